# Optimizing an MI355X kernel written in HIP

```python
import jax, jax.numpy as jnp
from jax import lax
import numpy as np

D_MODEL = 1024
BATCH = 8
SEQ = 8192
DEPTH = 2

GRID_W = 64
Q_BLOCK = 128
ROPE_THETA = 10000.0
EPS = 1e-6
MLA_HEADS = 6
MLA_NOPE = 64
MLA_ROPE = 32
MLA_V = 64
MLA_Q_RANK = 256
MLA_KV_RANK = 128
GQA_HEADS = 6
GQA_KV_HEADS = 2
GQA_DIM = 64
GMLP_GROUPS = 4
GMLP_DIM = 64
GMLP_CHUNK = 128
W_A = MLA_HEADS * MLA_V
W_B = GQA_HEADS * GQA_DIM
W_C = GMLP_GROUPS * GMLP_DIM
D_MIX = W_A + W_B + W_C
IN_SPLITS = (MLA_Q_RANK, MLA_KV_RANK, MLA_ROPE, W_B, GQA_KV_HEADS * GQA_DIM, GQA_KV_HEADS * GQA_DIM, 2 * W_C)
D_IN = 1568
MEM_TOKENS = 256
MEM_HEADS = 4
MEM_DIM = 128
D_FF = 2816
CONV_W = 3

kernel_name = "hybrid_mla_gqa_gmlp_encoder"


def rms_norm(x, g):
    xf = x.astype(jnp.float32)
    y = xf * lax.rsqrt(jnp.mean(xf * xf, axis=-1, keepdims=True) + EPS)
    return (y * g.astype(jnp.float32)).astype(x.dtype)


def axial_rope_table(S, d_rot):
    rows = S // GRID_W
    row = jnp.repeat(jnp.arange(rows, dtype=jnp.float32), GRID_W)
    col = jnp.tile(jnp.arange(GRID_W, dtype=jnp.float32), rows)
    n = d_rot // 4
    inv = ROPE_THETA ** (-jnp.arange(n, dtype=jnp.float32) / n)
    ang = jnp.concatenate([row[:, None] * inv, col[:, None] * inv], axis=-1)
    return jnp.cos(ang)[:, None, :], jnp.sin(ang)[:, None, :]


def apply_rope(x, cos, sin):
    d = x.shape[-1]
    xp = x.reshape(*x.shape[:-1], d // 2, 2)
    a, b = xp[..., 0], xp[..., 1]
    c, s = cos.astype(x.dtype), sin.astype(x.dtype)
    return jnp.stack([a * c - b * s, a * s + b * c], axis=-1).reshape(x.shape)


def block_attention(q, k, v, scale):
    B, S, H, dk = q.shape
    Hk, dv = k.shape[2], v.shape[-1]
    G = H // Hk
    nb = S // Q_BLOCK
    qb = q.reshape(B, nb, Q_BLOCK, Hk, G, dk).transpose(1, 0, 2, 3, 4, 5)

    def one_block(qi):
        s = jnp.einsum('bqhgd,bkhd->bhgqk', qi, k, preferred_element_type=jnp.float32) * scale
        p = jax.nn.softmax(s, axis=-1).astype(v.dtype)
        return jnp.einsum('bhgqk,bkhe->bqhge', p, v)

    ob = lax.map(one_block, qb)
    return ob.transpose(1, 0, 2, 3, 4, 5).reshape(B, S, H * dv)


def hybrid_mixer(h, rope_a, rope_b, w_in, mla_q_norm, mla_w_uq, mla_kv_norm, mla_w_ukv,
                 gqa_q_norm, gqa_k_norm, gmlp_v_norm, gmlp_w_s, gmlp_b_s, out_norm, w_out):
    B, S, _ = h.shape
    z = h @ w_in
    offs = [int(i) for i in np.cumsum(IN_SPLITS)[:-1]]
    c_q, c_kv, k_rope, g_q, g_k, g_v, g_m = jnp.split(z, offs, axis=-1)

    qa = (rms_norm(c_q, mla_q_norm) @ mla_w_uq).reshape(B, S, MLA_HEADS, MLA_NOPE + MLA_ROPE)
    q_nope, q_pe = qa[..., :MLA_NOPE], apply_rope(qa[..., MLA_NOPE:], *rope_a)
    kva = (rms_norm(c_kv, mla_kv_norm) @ mla_w_ukv).reshape(B, S, MLA_HEADS, MLA_NOPE + MLA_V)
    k_nope, v_a = kva[..., :MLA_NOPE], kva[..., MLA_NOPE:]
    k_pe = apply_rope(k_rope.reshape(B, S, 1, MLA_ROPE), *rope_a)
    q_a = jnp.concatenate([q_nope, q_pe], axis=-1)
    k_a = jnp.concatenate([k_nope, jnp.broadcast_to(k_pe, (B, S, MLA_HEADS, MLA_ROPE))], axis=-1)
    y_a = block_attention(q_a, k_a, v_a, (MLA_NOPE + MLA_ROPE) ** -0.5)

    q_b = apply_rope(rms_norm(g_q.reshape(B, S, GQA_HEADS, GQA_DIM), gqa_q_norm), *rope_b)
    k_b = apply_rope(rms_norm(g_k.reshape(B, S, GQA_KV_HEADS, GQA_DIM), gqa_k_norm), *rope_b)
    v_b = g_v.reshape(B, S, GQA_KV_HEADS, GQA_DIM)
    y_b = block_attention(q_b, k_b, v_b, GQA_DIM ** -0.5)

    g_m = jax.nn.gelu(g_m)
    u, vv = g_m[..., :W_C], g_m[..., W_C:]
    vv = rms_norm(vv, gmlp_v_norm).reshape(B, S // GMLP_CHUNK, GMLP_CHUNK, GMLP_GROUPS, GMLP_DIM)
    mixed = jnp.einsum('gpq,bnqgc->bnpgc', gmlp_w_s, vv) + gmlp_b_s.T[None, None, :, :, None]
    y_c = u * mixed.reshape(B, S, W_C)

    y = jnp.concatenate([rms_norm(y_a, out_norm[:W_A]),
                         rms_norm(y_b, out_norm[W_A:W_A + W_B]),
                         rms_norm(y_c, out_norm[W_A + W_B:])], axis=-1)
    return y @ w_out


def memory_cross_attention(h, mem, mem_kv_norm, mem_w_q, mem_w_kv, mem_w_o):
    B, S, _ = h.shape
    T = mem.shape[1]
    q = (h @ mem_w_q).reshape(B, S, MEM_HEADS, MEM_DIM)
    kv = rms_norm(mem, mem_kv_norm) @ mem_w_kv
    k = kv[..., :MEM_HEADS * MEM_DIM].reshape(B, T, MEM_HEADS, MEM_DIM)
    v = kv[..., MEM_HEADS * MEM_DIM:].reshape(B, T, MEM_HEADS, MEM_DIM)
    return block_attention(q, k, v, MEM_DIM ** -0.5) @ mem_w_o


def conv_gated_ffn(h, w_up, conv_w, conv_b, w_down):
    a = h @ w_up
    ap = jnp.pad(a, ((0, 0), (1, 1), (0, 0)))
    a = ap[:, :-2] * conv_w[0] + ap[:, 1:-1] * conv_w[1] + ap[:, 2:] * conv_w[2] + conv_b
    gate, val = a[..., :D_FF], a[..., D_FF:]
    return (jax.nn.silu(gate) * val) @ w_down


def setup_inputs(seed: int = 0) -> dict:
    key = jax.random.key(seed)
    ks = iter(jax.random.split(key, 48))

    def nrm(shape, scale):
        return jax.random.normal(next(ks), shape, jnp.float32) * scale

    def gain(shape):
        return 1.0 + nrm(shape, 0.05)

    L = DEPTH
    return {
        "x": nrm((BATCH, SEQ, D_MODEL), 1.0),
        "mem": nrm((BATCH, MEM_TOKENS, D_MODEL), 1.0),
        "mix_norm": gain((L, D_MODEL)),
        "w_in": nrm((L, D_MODEL, D_IN), D_MODEL ** -0.5),
        "mla_q_norm": gain((L, MLA_Q_RANK)),
        "mla_w_uq": nrm((L, MLA_Q_RANK, MLA_HEADS * (MLA_NOPE + MLA_ROPE)), MLA_Q_RANK ** -0.5),
        "mla_kv_norm": gain((L, MLA_KV_RANK)),
        "mla_w_ukv": nrm((L, MLA_KV_RANK, MLA_HEADS * (MLA_NOPE + MLA_V)), MLA_KV_RANK ** -0.5),
        "gqa_q_norm": gain((L, GQA_DIM)),
        "gqa_k_norm": gain((L, GQA_DIM)),
        "gmlp_v_norm": gain((L, W_C)),
        "gmlp_w_s": nrm((L, GMLP_GROUPS, GMLP_CHUNK, GMLP_CHUNK), GMLP_CHUNK ** -0.5),
        "gmlp_b_s": gain((L, GMLP_GROUPS, GMLP_CHUNK)),
        "out_norm": gain((L, D_MIX)),
        "w_out": nrm((L, D_MIX, D_MODEL), D_MIX ** -0.5),
        "mem_x_norm": gain((L, D_MODEL)),
        "mem_kv_norm": gain((L, D_MODEL)),
        "mem_w_q": nrm((L, D_MODEL, MEM_HEADS * MEM_DIM), D_MODEL ** -0.5),
        "mem_w_kv": nrm((L, D_MODEL, 2 * MEM_HEADS * MEM_DIM), D_MODEL ** -0.5),
        "mem_w_o": nrm((L, MEM_HEADS * MEM_DIM, D_MODEL), (MEM_HEADS * MEM_DIM) ** -0.5),
        "ffn_norm": gain((L, D_MODEL)),
        "ffn_w_up": nrm((L, D_MODEL, 2 * D_FF), D_MODEL ** -0.5),
        "ffn_conv_w": nrm((L, CONV_W, 2 * D_FF), CONV_W ** -0.5),
        "ffn_conv_b": nrm((L, 2 * D_FF), 0.01),
        "ffn_w_down": nrm((L, D_FF, D_MODEL), D_FF ** -0.5),
        "final_norm": gain((D_MODEL,)),
    }


def reference(x, mem, mix_norm, w_in, mla_q_norm, mla_w_uq, mla_kv_norm, mla_w_ukv,
              gqa_q_norm, gqa_k_norm, gmlp_v_norm, gmlp_w_s, gmlp_b_s, out_norm, w_out,
              mem_x_norm, mem_kv_norm, mem_w_q, mem_w_kv, mem_w_o,
              ffn_norm, ffn_w_up, ffn_conv_w, ffn_conv_b, ffn_w_down, final_norm):
    S = x.shape[1]
    rope_a = axial_rope_table(S, MLA_ROPE)
    rope_b = axial_rope_table(S, GQA_DIM)
    for l in range(DEPTH):
        h = rms_norm(x, mix_norm[l])
        x = x + hybrid_mixer(h, rope_a, rope_b, w_in[l], mla_q_norm[l], mla_w_uq[l], mla_kv_norm[l],
                             mla_w_ukv[l], gqa_q_norm[l], gqa_k_norm[l], gmlp_v_norm[l], gmlp_w_s[l],
                             gmlp_b_s[l], out_norm[l], w_out[l])
        h = rms_norm(x, mem_x_norm[l])
        x = x + memory_cross_attention(h, mem, mem_kv_norm[l], mem_w_q[l], mem_w_kv[l], mem_w_o[l])
        h = rms_norm(x, ffn_norm[l])
        x = x + conv_gated_ffn(h, ffn_w_up[l], ffn_conv_w[l], ffn_conv_b[l], ffn_w_down[l])
    return rms_norm(x, final_norm)
```

```cpp
#include <hip/hip_runtime.h>
#include <hip/hip_cooperative_groups.h>
#include <cstdio>
namespace cg = cooperative_groups;

typedef unsigned short u16;
typedef __attribute__((ext_vector_type(8))) short bf16x8;
typedef __attribute__((ext_vector_type(4))) short s16x4;
typedef __attribute__((ext_vector_type(16))) float f32x16;
typedef __attribute__((ext_vector_type(2))) __bf16 bf2_t;
typedef __attribute__((ext_vector_type(2))) float f2_t;
typedef __attribute__((address_space(3))) s16x4 lds_s16x4;
typedef __attribute__((ext_vector_type(4))) unsigned u32x4;

#define DI __device__ __forceinline__
#define MFMA(a, b, c) __builtin_amdgcn_mfma_f32_32x32x16_bf16((a), (b), (c), 0, 0, 0)

constexpr int NTOK = 65536, SEQ = 8192, NB = 8, DM = 1024, DIN = 1568, DFF = 2816, NMEM = 2048;
constexpr float LOG2E = 1.4426950408889634f;
constexpr float EPSF = 1e-6f;
constexpr int NTHR = 512, NWAVE = 8;

constexpr size_t MiB = 1ull << 20;
constexpr size_t W_IN = 0, W_UQ = W_IN + 1568ull * 1024, W_UKV = W_UQ + 576ull * 256, W_OUT = W_UKV + 768ull * 128,
                 W_MQ = W_OUT + 1024ull * 1024, W_MKV = W_MQ + 512ull * 1024, W_MO = W_MKV + 1024ull * 1024,
                 W_UP = W_MO + 1024ull * 512, W_DN = W_UP + 5632ull * 1024, W_S = W_DN + 1024ull * 2816,
                 W_LAYER = W_S + 4ull * 128 * 128;
constexpr size_t OFF_W = 0;
constexpr size_t OFF_ROPE = 56 * MiB;
constexpr size_t OFF_MEMN = 60 * MiB;
constexpr size_t OFF_MEMKV = 68 * MiB;
constexpr size_t OFF_H = 76 * MiB;
constexpr size_t OFF_Z = 204 * MiB;
constexpr size_t OFF_Y = 556 * MiB;
constexpr size_t OFF_QA = 684 * MiB;
constexpr size_t OFF_KA = 756 * MiB;
constexpr size_t OFF_VA = 828 * MiB;
constexpr size_t OFF_BAR = 940 * MiB;

struct Params {
  const float* in[26];
  float* out;
  char* ws;
};

DI int tid_opaque() { int t = threadIdx.x; asm volatile("" : "+v"(t)); return t; }
DI void gload16(u32x4& r, const void* p) { asm volatile("global_load_dwordx4 %0, %1, off" : "=v"(r) : "v"(p) : "memory"); }
DI void glds16(const void* gsrc, unsigned lds_dst) {
  unsigned keep;
  asm volatile("s_mov_b32 %0, m0\n\ts_mov_b32 m0, %2\n\ts_nop 0\n\tglobal_load_lds_dwordx4 %1, off\n\ts_mov_b32 m0, %0" : "=&s"(keep) : "v"(gsrc), "s"(lds_dst) : "memory");
}
#define VM_WAIT(n) asm volatile("s_waitcnt vmcnt(" #n ")" ::: "memory")
#define TIE(x) asm volatile("" : "+v"(x))
DI unsigned pk2(float a, float b) { f2_t v = {a, b}; bf2_t r = __builtin_convertvector(v, bf2_t); return __builtin_bit_cast(unsigned, r); }
DI float bflo(unsigned u) { return __uint_as_float(u << 16); }
DI float bfhi(unsigned u) { return __uint_as_float(u & 0xffff0000u); }
DI float wave_sum(float v) {
#pragma unroll
  for (int o = 32; o; o >>= 1) v += __shfl_xor(v, o);
  return v;
}
DI float half_sum(float v) {
#pragma unroll
  for (int o = 16; o; o >>= 1) v += __shfl_xor(v, o);
  return v;
}
DI float xhalf(float v, int h) {
  auto r = __builtin_amdgcn_permlane32_swap(__float_as_uint(v), __float_as_uint(v), false, false);
  return __uint_as_float(h ? r[0] : r[1]);
}
DI float dpp_xor1(float v) {
  return __uint_as_float(__builtin_amdgcn_update_dpp(0u, __float_as_uint(v), 0xB1, 0xf, 0xf, true));
}
DI void store_pair16(u16* p8k, uint2 a, uint2 b, int h) {
  auto r0 = __builtin_amdgcn_permlane32_swap(a.x, b.x, false, false);
  auto r1 = __builtin_amdgcn_permlane32_swap(a.y, b.y, false, false);
  uint4 v = {r0[0], r1[0], r0[1], r1[1]};
  *(uint4*)(p8k + (h ? 8 : 0)) = v;
}
DI float gelu_tanh(float x) {
  float y = 0.7978845608028654f * (x + 0.044715f * x * x * x);
  float e = __expf(2.f * y);
  float th = 1.f - 2.f / (1.f + e);
  return 0.5f * x * (1.f + th);
}

DI void transpose_phase(const float* __restrict__ in, int K, int N, u16* __restrict__ out, bool ffn_perm, char* smem) {
  const int tt = tid_opaque();
  const int half = tt >> 8, t = tt & 255;
  float(*tile)[33] = (float(*)[33])(smem + half * (64 * 33 * 4));
  const int nkt = K / 64, nnt = N / 32, njobs = nkt * nnt;
  for (int jp = blockIdx.x; jp * 2 < njobs; jp += gridDim.x) {
    const int job = jp * 2 + half;
    const bool ok = job < njobs;
    const int kt = job % nkt, ntile = job / nkt;
    const int kbase = kt * 64, nbase = ntile * 32;
    const int src = ffn_perm ? ((ntile & 1) * DFF + (ntile >> 1) * 32) : nbase;
    if (ok) {
#pragma unroll
      for (int it = 0; it < 2; ++it) {
        const int k = it * 32 + (t >> 3), n4 = (t & 7) * 4;
        const float4 v = *(const float4*)(in + (size_t)(kbase + k) * N + src + n4);
        tile[k][n4] = v.x; tile[k][n4 + 1] = v.y; tile[k][n4 + 2] = v.z; tile[k][n4 + 3] = v.w;
      }
    }
    __syncthreads();
    if (ok) {
      int n = t >> 3, kq = t & 7;
      float v[8];
#pragma unroll
      for (int j = 0; j < 8; ++j) v[j] = tile[kq * 8 + j][n];
      uint4 r = {pk2(v[0], v[1]), pk2(v[2], v[3]), pk2(v[4], v[5]), pk2(v[6], v[7])};
      *(uint4*)(out + (size_t)(nbase + n) * K + kbase + kq * 8) = r;
    }
    __syncthreads();
  }
}

DI void norm_rows_bf16(const float* __restrict__ x, const float* __restrict__ gain, u16* __restrict__ out, int rows) {
  const int t = tid_opaque();
  const int lane = t & 63;
  const int wid = blockIdx.x * NWAVE + (t >> 6), nw = gridDim.x * NWAVE;
  float4 g[4];
#pragma unroll
  for (int j = 0; j < 4; ++j) g[j] = *(const float4*)(gain + j * 256 + lane * 4);
  for (int r = wid; r < rows; r += nw) {
    const float* xr = x + (size_t)r * DM;
    float4 v[4];
    float ss = 0.f;
#pragma unroll
    for (int j = 0; j < 4; ++j) {
      v[j] = *(const float4*)(xr + j * 256 + lane * 4);
      ss += v[j].x * v[j].x + v[j].y * v[j].y + v[j].z * v[j].z + v[j].w * v[j].w;
    }
    ss = wave_sum(ss);
    const float rs = rsqrtf(ss * (1.f / DM) + EPSF);
#pragma unroll
    for (int j = 0; j < 4; ++j) {
      uint2 o = {pk2(v[j].x * rs * g[j].x, v[j].y * rs * g[j].y), pk2(v[j].z * rs * g[j].z, v[j].w * rs * g[j].w)};
      *(uint2*)(out + (size_t)r * DM + j * 256 + lane * 4) = o;
    }
  }
}

DI void final_norm_rows(float* __restrict__ x, const float* __restrict__ gain, int rows) {
  const int t = tid_opaque();
  const int lane = t & 63;
  const int wid = blockIdx.x * NWAVE + (t >> 6), nw = gridDim.x * NWAVE;
  float4 g[4];
#pragma unroll
  for (int j = 0; j < 4; ++j) g[j] = *(const float4*)(gain + j * 256 + lane * 4);
  for (int r = wid; r < rows; r += nw) {
    float* xr = x + (size_t)r * DM;
    float4 v[4];
    float ss = 0.f;
#pragma unroll
    for (int j = 0; j < 4; ++j) {
      v[j] = *(const float4*)(xr + j * 256 + lane * 4);
      ss += v[j].x * v[j].x + v[j].y * v[j].y + v[j].z * v[j].z + v[j].w * v[j].w;
    }
    ss = wave_sum(ss);
    const float rs = rsqrtf(ss * (1.f / DM) + EPSF);
#pragma unroll
    for (int j = 0; j < 4; ++j) {
      float4 o = {v[j].x * rs * g[j].x, v[j].y * rs * g[j].y, v[j].z * rs * g[j].z, v[j].w * rs * g[j].w};
      *(float4*)(xr + j * 256 + lane * 4) = o;
    }
  }
}

struct PostArgs {
  u16* z; u16* ka;
  const float *qn, *kvn, *gq, *gk, *gv;
  const float *cosA, *sinA, *cosB, *sinB;
};
DI void post_phase(const PostArgs& a) {
  const int t = tid_opaque();
  const int lane = t & 63, l32 = lane & 31, hh = lane >> 5;
  const int wid = blockIdx.x * NWAVE + (t >> 6), nw = gridDim.x * NWAVE;
  const float qscale = 0.125f * LOG2E;
  for (int tok = wid; tok < NTOK; tok += nw) {
    u16* zr = a.z + (size_t)tok * DIN;
    const int s = tok & (SEQ - 1);
    uint2 cq = *(const uint2*)(zr + lane * 4);
    unsigned ckv = *(const unsigned*)(zr + 256 + lane * 2);
    unsigned kr = *(const unsigned*)(zr + 384 + (lane & 15) * 2);
    unsigned gq[3];
#pragma unroll
    for (int it = 0; it < 3; ++it) gq[it] = *(const unsigned*)(zr + 416 + (it * 2 + hh) * 64 + l32 * 2);
    unsigned gk = *(const unsigned*)(zr + 800 + hh * 64 + l32 * 2);
    uint4 gm = *(const uint4*)(zr + 1056 + lane * 8);
    {
      float v0 = bflo(cq.x), v1 = bfhi(cq.x), v2 = bflo(cq.y), v3 = bfhi(cq.y);
      float ss = wave_sum(v0 * v0 + v1 * v1 + v2 * v2 + v3 * v3);
      float rs = rsqrtf(ss * (1.f / 256.f) + EPSF);
      float4 g = *(const float4*)(a.qn + lane * 4);
      uint2 o = {pk2(v0 * rs * g.x, v1 * rs * g.y), pk2(v2 * rs * g.z, v3 * rs * g.w)};
      *(uint2*)(zr + lane * 4) = o;
    }
    {
      float v0 = bflo(ckv), v1 = bfhi(ckv);
      float ss = wave_sum(v0 * v0 + v1 * v1);
      float rs = rsqrtf(ss * (1.f / 128.f) + EPSF);
      float2 g = *(const float2*)(a.kvn + lane * 2);
      *(unsigned*)(zr + 256 + lane * 2) = pk2(v0 * rs * g.x, v1 * rs * g.y);
    }
    if (lane < 16) {
      float x0 = bflo(kr), x1 = bfhi(kr);
      float c = a.cosA[s * 16 + lane], sn = a.sinA[s * 16 + lane];
      unsigned o = pk2(x0 * c - x1 * sn, x0 * sn + x1 * c);
#pragma unroll
      for (int hd = 0; hd < 6; ++hd) *(unsigned*)(a.ka + (size_t)tok * 576 + hd * 96 + 64 + lane * 2) = o;
    }
    {
      float2 g = *(const float2*)(a.gq + l32 * 2);
      float c = a.cosB[s * 32 + l32], sn = a.sinB[s * 32 + l32];
#pragma unroll
      for (int it = 0; it < 3; ++it) {
        float v0 = bflo(gq[it]), v1 = bfhi(gq[it]);
        float ss = half_sum(v0 * v0 + v1 * v1);
        float rs = rsqrtf(ss * (1.f / 64.f) + EPSF);
        v0 *= rs * g.x; v1 *= rs * g.y;
        *(unsigned*)(zr + 416 + (it * 2 + hh) * 64 + l32 * 2) = pk2((v0 * c - v1 * sn) * qscale, (v0 * sn + v1 * c) * qscale);
      }
      float2 g2 = *(const float2*)(a.gk + l32 * 2);
      float v0 = bflo(gk), v1 = bfhi(gk);
      float ss = half_sum(v0 * v0 + v1 * v1);
      float rs = rsqrtf(ss * (1.f / 64.f) + EPSF);
      v0 *= rs * g2.x; v1 *= rs * g2.y;
      *(unsigned*)(zr + 800 + hh * 64 + l32 * 2) = pk2(v0 * c - v1 * sn, v0 * sn + v1 * c);
    }
    {
      float v[8] = {bflo(gm.x), bfhi(gm.x), bflo(gm.y), bfhi(gm.y), bflo(gm.z), bfhi(gm.z), bflo(gm.w), bfhi(gm.w)};
      float ss = 0.f;
#pragma unroll
      for (int j = 0; j < 8; ++j) { v[j] = gelu_tanh(v[j]); ss += v[j] * v[j]; }
      ss = hh ? ss : 0.f;
      ss = wave_sum(ss);
      float rs = rsqrtf(ss * (1.f / 256.f) + EPSF);
      if (hh) {
        float4 g0 = *(const float4*)(a.gv + l32 * 8), g1 = *(const float4*)(a.gv + l32 * 8 + 4);
        v[0] *= rs * g0.x; v[1] *= rs * g0.y; v[2] *= rs * g0.z; v[3] *= rs * g0.w;
        v[4] *= rs * g1.x; v[5] *= rs * g1.y; v[6] *= rs * g1.z; v[7] *= rs * g1.w;
      }
      uint4 o = {pk2(v[0], v[1]), pk2(v[2], v[3]), pk2(v[4], v[5]), pk2(v[6], v[7])};
      *(uint4*)(zr + 1056 + lane * 8) = o;
    }
  }
}

DI void outnorm_rows(const u16* __restrict__ y, const float* __restrict__ gain, u16* __restrict__ out, int row0) {
  const int t = tid_opaque();
  const int lane = t & 63;
  const int rbeg = row0 + (t >> 6) * 32;
  const int seg = lane < 24 ? 0 : (lane < 48 ? 1 : 2);
  float g[16];
#pragma unroll
  for (int j = 0; j < 4; ++j) {
    float4 t4 = *(const float4*)(gain + lane * 16 + j * 4);
    g[j * 4] = t4.x; g[j * 4 + 1] = t4.y; g[j * 4 + 2] = t4.z; g[j * 4 + 3] = t4.w;
  }
  for (int r = rbeg; r < rbeg + 32; ++r) {
    const u16* yr = y + (size_t)r * DM + lane * 16;
    uint4 a = *(const uint4*)yr, b = *(const uint4*)(yr + 8);
    float v[16] = {bflo(a.x), bfhi(a.x), bflo(a.y), bfhi(a.y), bflo(a.z), bfhi(a.z), bflo(a.w), bfhi(a.w),
                   bflo(b.x), bfhi(b.x), bflo(b.y), bfhi(b.y), bflo(b.z), bfhi(b.z), bflo(b.w), bfhi(b.w)};
    float ss = 0.f;
#pragma unroll
    for (int j = 0; j < 16; ++j) ss += v[j] * v[j];
    float s0 = wave_sum(seg == 0 ? ss : 0.f), s1 = wave_sum(seg == 1 ? ss : 0.f), s2 = wave_sum(seg == 2 ? ss : 0.f);
    float rs = seg == 0 ? rsqrtf(s0 * (1.f / 384.f) + EPSF) : (seg == 1 ? rsqrtf(s1 * (1.f / 384.f) + EPSF) : rsqrtf(s2 * (1.f / 256.f) + EPSF));
#pragma unroll
    for (int j = 0; j < 16; ++j) v[j] *= rs * g[j];
    uint4 o0 = {pk2(v[0], v[1]), pk2(v[2], v[3]), pk2(v[4], v[5]), pk2(v[6], v[7])};
    uint4 o1 = {pk2(v[8], v[9]), pk2(v[10], v[11]), pk2(v[12], v[13]), pk2(v[14], v[15])};
    u16* orow = out + (size_t)r * DM + lane * 16;
    *(uint4*)orow = o0; *(uint4*)(orow + 8) = o1;
  }
}

enum { EPI_BF16 = 0, EPI_QA = 1, EPI_KVA = 2, EPI_RESID = 3 };
struct GemmArgs {
  const u16* A; int lda;
  const u16* W; int ldw;
  int M, N, K, epi;
  u16* out; int ldo; float scale;
  u16* out2;
  const float* res; float* outf;
  const float *cosA, *sinA;
  const float *convw, *convb;
};
constexpr int G_ROW = 128;
constexpr int G_STAGE = (256 + 256) * G_ROW;
constexpr int FFN_MT_PER_SEQ = 33;

template <bool FFN>
DI void gemm_tile(const GemmArgs& g, int mt, int nt, char* smem) {
  const int t = tid_opaque(), lane = t & 63, w = t >> 6, l32 = lane & 31, h = lane >> 5;
  const int wm_ = w >> 2, wn_ = w & 3;
  const int m0 = mt * 256, n0 = nt * 256;
  const int prw = lane >> 3, pslot = lane & 7;
  const u16* asrc[4]; const u16* wsrc[4];
#pragma unroll
  for (int i = 0; i < 4; ++i) {
    const int r = (w * 4 + i) * 8 + prw;
    const int gr = pslot ^ ((r >> 1) & 7);
    size_t grow;
    if (FFN) {
      const int b = mt / FFN_MT_PER_SEQ, ti = mt % FFN_MT_PER_SEQ;
      int tok = ti * 252 - 1 + r - (r >= 128 ? 2 : 0);
      tok = tok < 0 ? 0 : (tok >= SEQ ? SEQ - 1 : tok);
      grow = (size_t)b * SEQ + tok;
    } else grow = (size_t)m0 + r;
    asrc[i] = g.A + grow * g.lda + gr * 8;
    int n = n0 + r; n = n < g.N ? n : 0;
    wsrc[i] = g.W + (size_t)n * g.ldw + gr * 8;
  }
  int nv = (g.N - (n0 + wn_ * 64)) >> 5;
  nv = nv < 0 ? 0 : (nv > 2 ? 2 : nv);
  nv = __builtin_amdgcn_readfirstlane(nv);

  f32x16 acc[4][2];
#pragma unroll
  for (int mi = 0; mi < 4; ++mi)
#pragma unroll
    for (int ni = 0; ni < 2; ++ni)
#pragma unroll
      for (int r = 0; r < 16; ++r) acc[mi][ni][r] = 0.f;

  const int nk = g.K >> 6;
  const unsigned lds_w = __builtin_amdgcn_readfirstlane((unsigned)(size_t)smem + (unsigned)(w * 4096));
  const int sw = (l32 >> 1) & 7;
  const char* const fr_a = smem + (wm_ * 128 + l32) * G_ROW;
  const char* const fr_w = smem + 256 * G_ROW + (wn_ * 64 + l32) * G_ROW;

#define G_DMA(kt, stg)                                                          \
  {                                                                             \
    _Pragma("unroll") for (int i = 0; i < 4; ++i) {                             \
      glds16(asrc[i] + (kt) * 64, lds_w + (stg) * G_STAGE + i * 1024);          \
      glds16(wsrc[i] + (kt) * 64, lds_w + (stg) * G_STAGE + 256 * G_ROW + i * 1024); \
    }                                                                           \
  }
#define G_COMPUTE_N(stg, NIV)                                                   \
  {                                                                             \
    _Pragma("unroll") for (int k2 = 0; k2 < 4; k2 += 2) {                       \
      bf16x8 af[2][4], wf[2][2];                                                \
      _Pragma("unroll") for (int u = 0; u < 2; ++u) {                           \
        const int ko = (((k2 + u) * 2 + h) ^ sw) * 16;                          \
        wf[u][0] = *(const bf16x8*)(fr_w + (stg) * G_STAGE + ko);               \
        _Pragma("unroll") for (int mi = 0; mi < 4; ++mi) af[u][mi] = *(const bf16x8*)(fr_a + (stg) * G_STAGE + mi * 32 * G_ROW + ko); \
        if (NIV > 1) wf[u][1] = *(const bf16x8*)(fr_w + (stg) * G_STAGE + 32 * G_ROW + ko);  \
      }                                                                         \
      __builtin_amdgcn_sched_barrier(0);                                        \
      _Pragma("unroll") for (int u = 0; u < 2; ++u) {                           \
        _Pragma("unroll") for (int ni = 0; ni < NIV; ++ni) {                    \
          _Pragma("unroll") for (int mi = 0; mi < 4; ++mi) {                    \
            if (FFN) acc[mi][ni] = MFMA(af[u][mi], wf[u][ni], acc[mi][ni]);     \
            else     acc[mi][ni] = MFMA(wf[u][ni], af[u][mi], acc[mi][ni]);     \
          }                                                                     \
        }                                                                       \
      }                                                                         \
      __builtin_amdgcn_sched_barrier(0);                                        \
    }                                                                           \
  }

  __builtin_amdgcn_s_waitcnt(0x0F70);
  G_DMA(0, 0);
  VM_WAIT(0);
  __syncthreads();
#define G_KLOOP(NIV)                                                            \
  for (int kt = 0; kt < nk; kt += 2) {                                          \
    G_DMA(kt + 1, 1);                                 \
    if (NIV > 0) G_COMPUTE_N(0, (NIV > 0 ? NIV : 1));                           \
    VM_WAIT(0);                                                                 \
    __syncthreads();                                                            \
    if (kt + 2 < nk) G_DMA(kt + 2, 0);                                          \
    if (NIV > 0) G_COMPUTE_N(1, (NIV > 0 ? NIV : 1));                           \
    VM_WAIT(0);                                                                 \
    __syncthreads();                                                            \
  }
  if (nv == 2) { G_KLOOP(2) } else if (nv == 1) { G_KLOOP(1) } else { G_KLOOP(0) }
#undef G_KLOOP
#undef G_COMPUTE_N
#undef G_DMA

  if (FFN) {
    const int ch = (nt * 4 + wn_) * 32 + l32;
    const float* cw = g.convw;
    const float gw0 = cw[ch], gw1 = cw[2 * DFF + ch], gw2 = cw[4 * DFF + ch], gb = g.convb[ch];
    const float vw0 = cw[DFF + ch], vw1 = cw[3 * DFF + ch], vw2 = cw[5 * DFF + ch], vb = g.convb[DFF + ch];
    const int b = mt / FFN_MT_PER_SEQ, ti = mt % FFN_MT_PER_SEQ;
    const int tok0 = ti * 252 - 1 + wm_ * 126;
#pragma unroll
    for (int mi = 0; mi < 4; ++mi)
#pragma unroll
      for (int q = 0; q < 4; ++q)
#pragma unroll
        for (int e = 0; e < 4; ++e) {
          const bool okr = (unsigned)(tok0 + mi * 32 + q * 8 + h * 4 + e) < (unsigned)SEQ;
          acc[mi][0][q * 4 + e] = okr ? acc[mi][0][q * 4 + e] : 0.f;
          acc[mi][1][q * 4 + e] = okr ? acc[mi][1][q * 4 + e] : 0.f;
        }
    float pprev0 = 0.f, pprev1 = 0.f;
    float ncur0 = xhalf(acc[0][0][0], h), ncur1 = xhalf(acc[0][1][0], h);
#pragma unroll
    for (int gi = 0; gi < 16; ++gi) {
      const int mi = gi >> 2, q = gi & 3;
      float a0 = acc[mi][0][q * 4], a1 = acc[mi][0][q * 4 + 1], a2 = acc[mi][0][q * 4 + 2], a3 = acc[mi][0][q * 4 + 3];
      float b0 = acc[mi][1][q * 4], b1 = acc[mi][1][q * 4 + 1], b2 = acc[mi][1][q * 4 + 2], b3 = acc[mi][1][q * 4 + 3];
      float pg0 = xhalf(a3, h), pg1 = xhalf(b3, h);
      float nn0 = 0.f, nn1 = 0.f;
      if (gi < 15) {
        const int mi2 = (gi + 1) >> 2, q2 = (gi + 1) & 3;
        nn0 = xhalf(acc[mi2][0][q2 * 4], h);
        nn1 = xhalf(acc[mi2][1][q2 * 4], h);
      }
      float pa = h ? pg0 : pprev0, pb = h ? pg1 : pprev1;
      float na = h ? nn0 : ncur0, nb = h ? nn1 : ncur1;
      pprev0 = pg0; pprev1 = pg1; ncur0 = nn0; ncur1 = nn1;
      float cg[4], cv[4];
      cg[0] = gw0 * pa + gw1 * a0 + gw2 * a1 + gb;
      cg[1] = gw0 * a0 + gw1 * a1 + gw2 * a2 + gb;
      cg[2] = gw0 * a1 + gw1 * a2 + gw2 * a3 + gb;
      cg[3] = gw0 * a2 + gw1 * a3 + gw2 * na + gb;
      cv[0] = vw0 * pb + vw1 * b0 + vw2 * b1 + vb;
      cv[1] = vw0 * b0 + vw1 * b1 + vw2 * b2 + vb;
      cv[2] = vw0 * b1 + vw1 * b2 + vw2 * b3 + vb;
      cv[3] = vw0 * b2 + vw1 * b3 + vw2 * nb + vb;
      float sv[4];
#pragma unroll
      for (int e = 0; e < 4; ++e) {
        const float gt = cg[e];
        sv[e] = gt * __builtin_amdgcn_rcpf(1.f + __expf(-gt)) * cv[e];
      }
      {
        const int odd = l32 & 1;
        const float r0 = dpp_xor1(odd ? sv[0] : sv[2]), r1 = dpp_xor1(odd ? sv[1] : sv[3]);
        const unsigned w0 = odd ? pk2(r0, sv[2]) : pk2(sv[0], r0);
        const unsigned w1 = odd ? pk2(r1, sv[3]) : pk2(sv[1], r1);
        const int rowb = wm_ * 128 + mi * 32 + q * 8 + h * 4 + odd * 2;
        char* tp = smem + rowb * 272 + (wn_ * 32 + (l32 & ~1)) * 2;
        *(unsigned*)tp = w0;
        *(unsigned*)(tp + 272) = w1;
      }
      __builtin_amdgcn_sched_barrier(0);
    }
    __syncthreads();
    {
      const int chb = nt * 128;
#pragma unroll
      for (int i = 0; i < 8; ++i) {
        const int c = t + i * NTHR, row = c >> 4, cc = c & 15;
        const int lr = row & 127;
        const int tok = ti * 252 - 1 + (row >> 7) * 126 + lr;
        const uint4 v = *(const uint4*)(smem + row * 272 + cc * 16);
        if (lr >= 1 && lr <= 126 && tok < SEQ) *(uint4*)(g.out + (size_t)(b * SEQ + tok) * DFF + chb + cc * 8) = v;
      }
    }
    __syncthreads();
  } else {
#pragma unroll
    for (int mi = 0; mi < 4; ++mi) {
      const int m = m0 + wm_ * 128 + mi * 32 + l32;
#pragma unroll
      for (int ni = 0; ni < 2; ++ni) {
        if (ni < nv && g.epi == EPI_KVA) {
#pragma unroll
          for (int q = 0; q < 4; q += 2) {
            const int nb = n0 + wn_ * 64 + ni * 32 + q * 8;
            const int hd = nb >> 7, within = nb & 127;
            uint2 a = {pk2(acc[mi][ni][q * 4], acc[mi][ni][q * 4 + 1]), pk2(acc[mi][ni][q * 4 + 2], acc[mi][ni][q * 4 + 3])};
            uint2 b = {pk2(acc[mi][ni][q * 4 + 4], acc[mi][ni][q * 4 + 5]), pk2(acc[mi][ni][q * 4 + 6], acc[mi][ni][q * 4 + 7])};
            u16* dst = (within < 64) ? g.out + (size_t)m * 576 + hd * 96 + within : g.out2 + (size_t)m * 384 + hd * 64 + within - 64;
            store_pair16(dst, a, b, h);
          }
        } else if (ni < nv && (g.epi == EPI_BF16 || g.epi == EPI_QA)) {
          uint2 pkd[4];
#pragma unroll
          for (int q = 0; q < 4; ++q) {
            const int n = n0 + wn_ * 64 + ni * 32 + q * 8 + h * 4;
            float v0 = acc[mi][ni][q * 4], v1 = acc[mi][ni][q * 4 + 1], v2 = acc[mi][ni][q * 4 + 2], v3 = acc[mi][ni][q * 4 + 3];
            if (g.epi == EPI_QA) {
              const int within = n % 96;
              if (within >= 64) {
                const int s = m & (SEQ - 1), pi = (within - 64) >> 1;
                float c0 = g.cosA[s * 16 + pi], s0 = g.sinA[s * 16 + pi], c1 = g.cosA[s * 16 + pi + 1], s1 = g.sinA[s * 16 + pi + 1];
                float t0 = v0 * c0 - v1 * s0, t1 = v0 * s0 + v1 * c0, t2 = v2 * c1 - v3 * s1, t3 = v2 * s1 + v3 * c1;
                v0 = t0; v1 = t1; v2 = t2; v3 = t3;
              }
            }
            pkd[q].x = pk2(v0 * g.scale, v1 * g.scale); pkd[q].y = pk2(v2 * g.scale, v3 * g.scale);
          }
          u16* rowp = g.out + (size_t)m * g.ldo + n0 + wn_ * 64 + ni * 32;
          store_pair16(rowp, pkd[0], pkd[1], h);
          store_pair16(rowp + 16, pkd[2], pkd[3], h);
        } else if (ni < nv) {
#pragma unroll
          for (int q = 0; q < 4; ++q) {
            const int n = n0 + wn_ * 64 + ni * 32 + q * 8 + h * 4;
            float v0 = acc[mi][ni][q * 4], v1 = acc[mi][ni][q * 4 + 1], v2 = acc[mi][ni][q * 4 + 2], v3 = acc[mi][ni][q * 4 + 3];
            if (g.epi == EPI_QA) {
              const int within = n % 96;
              if (within >= 64) {
                const int s = m & (SEQ - 1), pi = (within - 64) >> 1;
                float c0 = g.cosA[s * 16 + pi], s0 = g.sinA[s * 16 + pi], c1 = g.cosA[s * 16 + pi + 1], s1 = g.sinA[s * 16 + pi + 1];
                float t0 = v0 * c0 - v1 * s0, t1 = v0 * s0 + v1 * c0, t2 = v2 * c1 - v3 * s1, t3 = v2 * s1 + v3 * c1;
                v0 = t0; v1 = t1; v2 = t2; v3 = t3;
              }
              uint2 o = {pk2(v0 * g.scale, v1 * g.scale), pk2(v2 * g.scale, v3 * g.scale)};
              *(uint2*)(g.out + (size_t)m * 576 + n) = o;
            } else if (g.epi == EPI_KVA) {
              const int hd = n >> 7, within = n & 127;
              uint2 o = {pk2(v0, v1), pk2(v2, v3)};
              if (within < 64) *(uint2*)(g.out + (size_t)m * 576 + hd * 96 + within) = o;
              else *(uint2*)(g.out2 + (size_t)m * 384 + hd * 64 + within - 64) = o;
            } else {
              float4 r = *(const float4*)(g.res + (size_t)m * DM + n);
              float4 o = {r.x + v0, r.y + v1, r.z + v2, r.w + v3};
              *(float4*)(g.outf + (size_t)m * DM + n) = o;
            }
          }
        }
        __builtin_amdgcn_sched_barrier(0);
      }
    }
  }
}

template <bool FFN>
DI void gemm_phase(const GemmArgs& g, char* smem) {
  const int MT = FFN ? NB * FFN_MT_PER_SEQ : g.M / 256;
  const int NT = (g.N + 255) / 256;
  const int njobs = MT * NT;
  const int MTx = MT >> 3;
  const int ngf = NT >> 2, jfull = MTx * 4;
  for (int j = blockIdx.x; j < njobs; j += gridDim.x) {
    const int x = j & 7, jj = j >> 3;
    int ng, rem, gn;
    if (jj < ngf * jfull) { ng = jj / jfull; rem = jj - ng * jfull; gn = 4; }
    else { ng = ngf; rem = jj - ngf * jfull; gn = NT & 3; }
    const int ml = rem / gn, nin = rem - ml * gn;
    const int mt = x + 8 * ml, nt = ng * 4 + nin;
    gemm_tile<FFN>(g, mt, nt, smem);
  }
}

DI float max3f(float a, float b, float c) { return fmaxf(fmaxf(a, b), c); }
DI float xhalf_max(float v) {
  auto r = __builtin_amdgcn_permlane32_swap(__float_as_uint(v), __float_as_uint(v), false, false);
  return fmaxf(__uint_as_float(r[0]), __uint_as_float(r[1]));
}
DI int prow(int i) { return (i & ~12) | ((i & 4) << 1) | ((i & 8) >> 1); }

template <int DK, int DV>
DI void attn_block(const u16* __restrict__ Q, int ldq, const u16* __restrict__ K, int ldk, const u16* __restrict__ V, int ldv,
                   u16* __restrict__ O, int ldo, int T, char* smem) {
  constexpr int KS = DK * 2 + 16, VS = DV * 2 + 64;
  constexpr int TK = (DK <= 96 && DV <= 64) ? 128 : 64;
  constexpr int NKB = TK / 32, NC = TK / 16;
  constexpr int KT = TK * KS, STG = KT + TK * VS;
  constexpr int KCH = DK / 8, VCH = DV / 8;
  constexpr int NK = (TK * KCH + NTHR - 1) / NTHR, NV = (TK * VCH + NTHR - 1) / NTHR;
  const int t = tid_opaque(), lane = t & 63, w = t >> 6, l32 = lane & 31, h = lane >> 5;

  bf16x8 qf[DK / 16];
#pragma unroll
  for (int kc = 0; kc < DK / 16; ++kc) qf[kc] = *(const bf16x8*)(Q + (size_t)(w * 32 + l32) * ldq + kc * 16 + h * 8);
#pragma unroll
  for (int kc = 0; kc < DK / 16; ++kc) asm volatile("" ::"v"(qf[kc]));

  f32x16 o[DV / 32];
#pragma unroll
  for (int d = 0; d < DV / 32; ++d)
#pragma unroll
    for (int r = 0; r < 16; ++r) o[d][r] = 0.f;
  float mref = 0.f;
  f32x16 negm;
#pragma unroll
  for (int r = 0; r < 16; ++r) negm[r] = 0.f;

  u32x4 rk[NK], rv[NV];
  const u16* kp[NK]; const u16* vp[NV];
  int ksto[NK], vsto[NV];
#pragma unroll
  for (int i = 0; i < NK; ++i) {
    int c = t + i * NTHR; if (c >= TK * KCH) c -= NTHR;
    int row = c / KCH, kc = c % KCH;
    kp[i] = K + (size_t)row * ldk + kc * 8;
    ksto[i] = row * KS + kc * 16;
  }
#pragma unroll
  for (int i = 0; i < NV; ++i) {
    int c = t + i * NTHR; if (c >= TK * VCH) c -= NTHR;
    int row = c / VCH, vc = c % VCH;
    vp[i] = V + (size_t)row * ldv + vc * 8;
    vsto[i] = KT + row * VS + vc * 16;
  }
#define A_LOAD(kt)                                                                                          \
  {                                                                                                         \
    _Pragma("unroll") for (int i = 0; i < NK; ++i) gload16(rk[i], kp[i] + (size_t)(kt) * TK * ldk); \
    _Pragma("unroll") for (int i = 0; i < NV; ++i) gload16(rv[i], vp[i] + (size_t)(kt) * TK * ldv); \
  }
#define A_STORE(stg)                                                                           \
  {                                                                                            \
    _Pragma("unroll") for (int i = 0; i < NK; ++i) *(u32x4*)(smem + (stg) * STG + ksto[i]) = rk[i]; \
    _Pragma("unroll") for (int i = 0; i < NV; ++i) *(u32x4*)(smem + (stg) * STG + vsto[i]) = rv[i]; \
  }
  const int nt = T / TK;
  const int kfr0 = prow(l32) * KS + h * 16;
  const int qq = (lane & 15) >> 2, pp = lane & 3, blk = (lane >> 4) & 1;
  const int vfr0 = KT + (8 * h + qq) * VS + blk * 32 + pp * 8;

#define A_TIE() { _Pragma("unroll") for (int i = 0; i < NK; ++i) TIE(rk[i]); _Pragma("unroll") for (int i = 0; i < NV; ++i) TIE(rv[i]); }
  __builtin_amdgcn_s_waitcnt(0x0F70);
  A_LOAD(0);
  VM_WAIT(0);
  A_TIE();
  A_STORE(0);
  __syncthreads();
  float lrun = 0.f;
  for (int kt = 0; kt < nt; ++kt) {
    const int stg = kt & 1;
    { const int ktn = (kt + 1 < nt) ? kt + 1 : kt; A_LOAD(ktn); }
    __builtin_amdgcn_sched_barrier(0);
    const char* sb = smem + stg * STG;
    f32x16 s[NKB];
#pragma unroll
    for (int kb2 = 0; kb2 < NKB; kb2 += 2) {
      bf16x8 kf[2][DK / 16];
#pragma unroll
      for (int kc = 0; kc < DK / 16; ++kc)
#pragma unroll
        for (int u = 0; u < 2; ++u) kf[u][kc] = *(const bf16x8*)(sb + kfr0 + (kb2 + u) * 32 * KS + kc * 32);
      s[kb2] = MFMA(kf[0][0], qf[0], negm);
      s[kb2 + 1] = MFMA(kf[1][0], qf[0], negm);
#pragma unroll
      for (int kc = 1; kc < DK / 16; ++kc) {
        s[kb2] = MFMA(kf[0][kc], qf[kc], s[kb2]);
        s[kb2 + 1] = MFMA(kf[1][kc], qf[kc], s[kb2 + 1]);
      }
    }
    float mx = max3f(s[0][0], s[0][1], s[0][2]);
#pragma unroll
    for (int r = 3; r < 15; r += 2) mx = max3f(mx, s[0][r], s[0][r + 1]);
    mx = fmaxf(mx, s[0][15]);
#pragma unroll
    for (int kb = 1; kb < NKB; ++kb) {
#pragma unroll
      for (int r = 0; r < 16; r += 2) mx = max3f(mx, s[kb][r], s[kb][r + 1]);
    }
    mx = xhalf_max(mx);
    if (kt == 0 || __builtin_amdgcn_ballot_w64(mx > 8.0f) != 0ull) {
      const float delta = (kt == 0) ? mx : fmaxf(mx, 0.f);
      const float alpha = (kt == 0) ? 1.f : __builtin_amdgcn_exp2f(-delta);
      mref += delta;
#pragma unroll
      for (int r = 0; r < 16; ++r) negm[r] = -mref;
      lrun *= alpha;
#pragma unroll
      for (int d = 0; d < DV / 32; ++d)
#pragma unroll
        for (int r = 0; r < 16; ++r) o[d][r] *= alpha;
#pragma unroll
      for (int kb = 0; kb < NKB; ++kb)
#pragma unroll
        for (int r = 0; r < 16; ++r) s[kb][r] -= delta;
    }
#define AT_EXPCVT(kb, PF)                                                                              \
    {                                                                                                  \
      _Pragma("unroll") for (int u = 0; u < 2; ++u) {                                                  \
        float e_[8];                                                                                   \
        _Pragma("unroll") for (int j = 0; j < 8; ++j) { e_[j] = __builtin_amdgcn_exp2f(s[kb][u * 8 + j]); lrun += e_[j]; } \
        uint4 pu_ = {pk2(e_[0], e_[1]), pk2(e_[2], e_[3]), pk2(e_[4], e_[5]), pk2(e_[6], e_[7])};      \
        PF[u] = __builtin_bit_cast(bf16x8, pu_);                                                       \
      }                                                                                                \
    }
#define AT_READV(kb, VF)                                                                               \
    {                                                                                                  \
      _Pragma("unroll") for (int u = 0; u < 2; ++u)                                                    \
        _Pragma("unroll") for (int d = 0; d < DV / 32; ++d) {                                          \
          const char* va = sb + vfr0 + ((kb) * 2 + u) * 16 * VS + d * 64;                              \
          s16x4 lo = __builtin_amdgcn_ds_read_tr16_b64_v4i16((lds_s16x4*)(va));                        \
          s16x4 hi = __builtin_amdgcn_ds_read_tr16_b64_v4i16((lds_s16x4*)(va + 4 * VS));              \
          VF[u][d] = __builtin_shufflevector(lo, hi, 0, 1, 2, 3, 4, 5, 6, 7);                          \
        }                                                                                              \
    }
#define AT_PVM(PF, VF)                                                                                 \
    {                                                                                                  \
      _Pragma("unroll") for (int u = 0; u < 2; ++u) {                                                  \
        _Pragma("unroll") for (int d = 0; d < DV / 32; ++d) o[d] = MFMA(VF[u][d], PF[u], o[d]);        \
      }                                                                                                \
    }
#define AT_SCHED_STAGE()     \
    {                                                                                                  \
      _Pragma("unroll") for (int i_ = 0; i_ < 2 * (DV / 32); ++i_) {                                     \
        __builtin_amdgcn_sched_group_barrier(0x008, 1, 0);                                             \
        __builtin_amdgcn_sched_group_barrier(0x002, (DV == 64) ? 10 : 5, 0);                           \
        __builtin_amdgcn_sched_group_barrier(0x100, 2, 0);                                             \
      }                                                                                                \
    }
    {
      bf16x8 pfA[2], pfB[2], vfA[2][DV / 32], vfB[2][DV / 32];
      AT_EXPCVT(0, pfA);
      AT_READV(0, vfA);
#pragma unroll
      for (int kb = 0; kb < NKB; kb += 2) {
        AT_EXPCVT(kb + 1, pfB);
        AT_READV(kb + 1, vfB);
        AT_PVM(pfA, vfA);
        if (kb + 2 < NKB) {
          AT_EXPCVT(kb + 2, pfA);
          AT_READV(kb + 2, vfA);
        }
        AT_PVM(pfB, vfB);
      }
      __builtin_amdgcn_sched_group_barrier(0x002, 44, 0);
      __builtin_amdgcn_sched_group_barrier(0x100, 4 * (DV / 32), 0);
#pragma unroll
      for (int st_ = 0; st_ < NKB - 1; ++st_) AT_SCHED_STAGE();
      __builtin_amdgcn_sched_group_barrier(0x008, 2 * (DV / 32), 0);
    }
#undef AT_EXPCVT
#undef AT_READV
#undef AT_PVM
#undef AT_SCHED_STAGE
    VM_WAIT(0);
    A_TIE();
    A_STORE(stg ^ 1);
    __syncthreads();
  }
#undef A_TIE
#undef A_LOAD
#undef A_STORE
  const float inv = 1.f / (lrun + xhalf(lrun, h));
  u16* orow = O + (size_t)(w * 32 + l32) * ldo;
#pragma unroll
  for (int d = 0; d < DV / 32; ++d)
#pragma unroll
    for (int q = 0; q < 4; q += 2) {
      uint2 oa = {pk2(o[d][q * 4] * inv, o[d][q * 4 + 1] * inv), pk2(o[d][q * 4 + 2] * inv, o[d][q * 4 + 3] * inv)};
      uint2 ob = {pk2(o[d][q * 4 + 4] * inv, o[d][q * 4 + 5] * inv), pk2(o[d][q * 4 + 6] * inv, o[d][q * 4 + 7] * inv)};
      store_pair16(orow + d * 32 + q * 8, oa, ob, h);
    }
}

template <int DK>
DI void attn_block_dma(const u16* __restrict__ Q, int ldq, const u16* __restrict__ K, int ldk, const u16* __restrict__ V, int ldv,
                   u16* __restrict__ O, int ldo, int T, char* smem) {
  constexpr int DV = 64, TK = 128, NKB = 4;
  constexpr int KBY = DK * 2, KG = DK / 8;
  constexpr int KT = TK * KBY, STG = KT + TK * 128;
  constexpr int NKP = KT / 1024, NPW = (NKP + 16) / 8;
  static_assert(2 * STG <= 2 * G_STAGE, "LDS");
  const int t = tid_opaque(), lane = t & 63, w = t >> 6, l32 = lane & 31, h = lane >> 5;

  bf16x8 qf[DK / 16];
#pragma unroll
  for (int kc = 0; kc < DK / 16; ++kc) qf[kc] = *(const bf16x8*)(Q + (size_t)(w * 32 + l32) * ldq + kc * 16 + h * 8);
#pragma unroll
  for (int kc = 0; kc < DK / 16; ++kc) asm volatile("" ::"v"(qf[kc]));

  f32x16 o[DV / 32];
#pragma unroll
  for (int d = 0; d < DV / 32; ++d)
#pragma unroll
    for (int r = 0; r < 16; ++r) o[d][r] = 0.f;
  float mref = 0.f;
  f32x16 negm;
#pragma unroll
  for (int r = 0; r < 16; ++r) negm[r] = 0.f;

  const u16* psrc[NPW]; unsigned pdst[NPW];
  const unsigned lds0 = (unsigned)(size_t)smem;
#pragma unroll
  for (int i = 0; i < NPW; ++i) {
    const int pz = w + 8 * i;
    if (i * 8 < NKP) {
      const int S = pz * 64 + lane, r = S / KG, slot = S % KG;
      const int gg = (DK == 64) ? (slot ^ ((r >> 1) & 7)) : ((slot + 12 - ((r >> 2) & 3)) % 12);
      psrc[i] = K + (size_t)r * ldk + gg * 8;
      pdst[i] = pz * 1024;
    } else {
      const int S = (pz - NKP) * 64 + lane, r = S >> 3, slot = S & 7;
      const int gg = slot ^ (((r >> 1) & 1) << 2);
      psrc[i] = V + (size_t)r * ldv + gg * 8;
      pdst[i] = KT + (pz - NKP) * 1024;
    }
  }
#define A_DMA(kt, stg)                                                                        \
  {                                                                                           \
    _Pragma("unroll") for (int i = 0; i < NPW; ++i)                                           \
      glds16(psrc[i] + (size_t)(kt) * TK * ((i * 8 < NKP) ? ldk : ldv),                       \
             __builtin_amdgcn_readfirstlane(lds0 + (stg) * STG + pdst[i]));                   \
  }
  const int nt = T / TK;
  const int krow = prow(l32);
  int kslot[DK / 16];
#pragma unroll
  for (int kc = 0; kc < DK / 16; ++kc) {
    if (DK == 64) kslot[kc] = ((kc * 2 + h) ^ ((krow >> 1) & 7)) * 16;
    else { const int tt = kc * 2 + h + ((krow >> 2) & 3); kslot[kc] = (tt >= 12 ? tt - 12 : tt) * 16; }
  }
  const int kfr0 = krow * KBY;
  const int qq = (lane & 15) >> 2, pp = lane & 3, blk = (lane >> 4) & 1;
  const int vxb = (qq >> 1) & 1;
  const int vfr0 = KT + (8 * h + qq) * 128 + (blk * 2 + (pp >> 1)) * 16 + (pp & 1) * 8;
  const int vd0 = vxb * 64, vd1 = (1 - vxb) * 64;

  __builtin_amdgcn_s_waitcnt(0x0F70);
  A_DMA(0, 0);
  VM_WAIT(0);
  __syncthreads();
  float lrun = 0.f;
  for (int kt = 0; kt < nt; ++kt) {
    const int stg = kt & 1;
    if (kt + 1 < nt) A_DMA(kt + 1, stg ^ 1);
    __builtin_amdgcn_sched_barrier(0);
    const char* sb = smem + stg * STG;
    f32x16 s[NKB];
#pragma unroll
    for (int kb2 = 0; kb2 < NKB; kb2 += 2) {
      bf16x8 kf[2][DK / 16];
#pragma unroll
      for (int kc = 0; kc < DK / 16; ++kc)
#pragma unroll
        for (int u = 0; u < 2; ++u) kf[u][kc] = *(const bf16x8*)(sb + kfr0 + (kb2 + u) * 32 * KBY + kslot[kc]);
      s[kb2] = MFMA(kf[0][0], qf[0], negm);
      s[kb2 + 1] = MFMA(kf[1][0], qf[0], negm);
#pragma unroll
      for (int kc = 1; kc < DK / 16; ++kc) {
        s[kb2] = MFMA(kf[0][kc], qf[kc], s[kb2]);
        s[kb2 + 1] = MFMA(kf[1][kc], qf[kc], s[kb2 + 1]);
      }
    }
    float mx = max3f(s[0][0], s[0][1], s[0][2]);
#pragma unroll
    for (int r = 3; r < 15; r += 2) mx = max3f(mx, s[0][r], s[0][r + 1]);
    mx = fmaxf(mx, s[0][15]);
#pragma unroll
    for (int kb = 1; kb < NKB; ++kb) {
#pragma unroll
      for (int r = 0; r < 16; r += 2) mx = max3f(mx, s[kb][r], s[kb][r + 1]);
    }
    mx = xhalf_max(mx);
    if (kt == 0 || __builtin_amdgcn_ballot_w64(mx > 8.0f) != 0ull) {
      const float delta = (kt == 0) ? mx : fmaxf(mx, 0.f);
      const float alpha = (kt == 0) ? 1.f : __builtin_amdgcn_exp2f(-delta);
      mref += delta;
#pragma unroll
      for (int r = 0; r < 16; ++r) negm[r] = -mref;
      lrun *= alpha;
#pragma unroll
      for (int d = 0; d < DV / 32; ++d)
#pragma unroll
        for (int r = 0; r < 16; ++r) o[d][r] *= alpha;
#pragma unroll
      for (int kb = 0; kb < NKB; ++kb)
#pragma unroll
        for (int r = 0; r < 16; ++r) s[kb][r] -= delta;
    }
#define AT_EXPCVT(kb, PF)                                                                              \
    {                                                                                                  \
      _Pragma("unroll") for (int u = 0; u < 2; ++u) {                                                  \
        float e_[8];                                                                                   \
        _Pragma("unroll") for (int j = 0; j < 8; ++j) { e_[j] = __builtin_amdgcn_exp2f(s[kb][u * 8 + j]); lrun += e_[j]; } \
        uint4 pu_ = {pk2(e_[0], e_[1]), pk2(e_[2], e_[3]), pk2(e_[4], e_[5]), pk2(e_[6], e_[7])};      \
        PF[u] = __builtin_bit_cast(bf16x8, pu_);                                                       \
      }                                                                                                \
    }
#define AT_READV(kb, VF)                                                                               \
    {                                                                                                  \
      _Pragma("unroll") for (int u = 0; u < 2; ++u)                                                    \
        _Pragma("unroll") for (int d = 0; d < DV / 32; ++d) {                                          \
          const char* va = sb + vfr0 + ((kb) * 2 + u) * 16 * 128 + (d ? vd1 : vd0);                    \
          s16x4 lo = __builtin_amdgcn_ds_read_tr16_b64_v4i16((lds_s16x4*)(va));                        \
          s16x4 hi = __builtin_amdgcn_ds_read_tr16_b64_v4i16((lds_s16x4*)(va + 4 * 128));             \
          VF[u][d] = __builtin_shufflevector(lo, hi, 0, 1, 2, 3, 4, 5, 6, 7);                          \
        }                                                                                              \
    }
#define AT_PVM(PF, VF)                                                                                 \
    {                                                                                                  \
      _Pragma("unroll") for (int u = 0; u < 2; ++u) {                                                  \
        _Pragma("unroll") for (int d = 0; d < DV / 32; ++d) o[d] = MFMA(VF[u][d], PF[u], o[d]);        \
      }                                                                                                \
    }
#define AT_SCHED_STAGE()     \
    {                                                                                                  \
      _Pragma("unroll") for (int i_ = 0; i_ < 2 * (DV / 32); ++i_) {                                     \
        __builtin_amdgcn_sched_group_barrier(0x008, 1, 0);                                             \
        __builtin_amdgcn_sched_group_barrier(0x002, (DV == 64) ? 10 : 5, 0);                           \
        __builtin_amdgcn_sched_group_barrier(0x100, 2, 0);                                             \
      }                                                                                                \
    }
    {
      bf16x8 pfA[2], pfB[2], vfA[2][DV / 32], vfB[2][DV / 32];
      AT_EXPCVT(0, pfA);
      AT_READV(0, vfA);
#pragma unroll
      for (int kb = 0; kb < NKB; kb += 2) {
        AT_EXPCVT(kb + 1, pfB);
        AT_READV(kb + 1, vfB);
        AT_PVM(pfA, vfA);
        if (kb + 2 < NKB) {
          AT_EXPCVT(kb + 2, pfA);
          AT_READV(kb + 2, vfA);
        }
        AT_PVM(pfB, vfB);
      }
      __builtin_amdgcn_sched_group_barrier(0x002, 44, 0);
      __builtin_amdgcn_sched_group_barrier(0x100, 4 * (DV / 32), 0);
#pragma unroll
      for (int st_ = 0; st_ < NKB - 1; ++st_) AT_SCHED_STAGE();
      __builtin_amdgcn_sched_group_barrier(0x008, 2 * (DV / 32), 0);
    }
#undef AT_EXPCVT
#undef AT_READV
#undef AT_PVM
#undef AT_SCHED_STAGE
    VM_WAIT(0);
    __syncthreads();
  }
#undef A_DMA
  const float inv = 1.f / (lrun + xhalf(lrun, h));
  u16* orow = O + (size_t)(w * 32 + l32) * ldo;
#pragma unroll
  for (int d = 0; d < DV / 32; ++d)
#pragma unroll
    for (int q = 0; q < 4; q += 2) {
      uint2 oa = {pk2(o[d][q * 4] * inv, o[d][q * 4 + 1] * inv), pk2(o[d][q * 4 + 2] * inv, o[d][q * 4 + 3] * inv)};
      uint2 ob = {pk2(o[d][q * 4 + 4] * inv, o[d][q * 4 + 5] * inv), pk2(o[d][q * 4 + 6] * inv, o[d][q * 4 + 7] * inv)};
      store_pair16(orow + d * 32 + q * 8, oa, ob, h);
    }
}

DI void gmlp_phase(const u16* __restrict__ z, const u16* __restrict__ ws_bf, const float* __restrict__ bs, u16* __restrict__ y, char* smem) {
  constexpr int VS = 64 * 2 + 64;
  const int t = tid_opaque(), lane = t & 63, w = t >> 6, l32 = lane & 31, h = lane >> 5;
  const int qq = (lane & 15) >> 2, pp = lane & 3, blk = (lane >> 4) & 1;
  for (int job = blockIdx.x; job < 512 * 2; job += gridDim.x) {
    const int chunk = job >> 1, grp = (job & 1) * 2 + (w >> 2);
    const size_t tok0 = (size_t)chunk * 128;
    char* const sm = smem + (w >> 2) * (128 * VS);
#pragma unroll
    for (int i = 0; i < 4; ++i) {
      int c = t + i * NTHR, gl = c >> 10, row = (c >> 3) & 127, vc = c & 7;
      uint4 v = *(const uint4*)(z + (tok0 + row) * DIN + 1312 + ((job & 1) * 2 + gl) * 64 + vc * 8);
      *(uint4*)(smem + gl * (128 * VS) + row * VS + vc * 16) = v;
    }
    __syncthreads();
    f32x16 acc[2];
#pragma unroll
    for (int d = 0; d < 2; ++d)
#pragma unroll
      for (int r = 0; r < 16; ++r) acc[d][r] = 0.f;
    const int p = (w & 3) * 32 + l32;
#pragma unroll
    for (int ks = 0; ks < 8; ++ks) {
      bf16x8 wf = *(const bf16x8*)(ws_bf + (size_t)grp * 16384 + p * 128 + ks * 16 + h * 8);
#pragma unroll
      for (int d = 0; d < 2; ++d) {
        const char* va = sm + (ks * 16 + 8 * h + qq) * VS + d * 64 + blk * 32 + pp * 8;
        s16x4 lo = __builtin_amdgcn_ds_read_tr16_b64_v4i16((lds_s16x4*)(va));
        s16x4 hi = __builtin_amdgcn_ds_read_tr16_b64_v4i16((lds_s16x4*)(va + 4 * VS));
        bf16x8 vf = __builtin_shufflevector(lo, hi, 0, 1, 2, 3, 4, 5, 6, 7);
        acc[d] = MFMA(vf, wf, acc[d]);
      }
    }
    const float bias = bs[grp * 128 + p];
    const u16* ur = z + (tok0 + p) * DIN + 1056 + grp * 64;
    u16* yr = y + (tok0 + p) * DM + 768 + grp * 64;
#pragma unroll
    for (int d = 0; d < 2; ++d)
#pragma unroll
      for (int q = 0; q < 4; q += 2) {
        uint2 ov[2];
#pragma unroll
        for (int k = 0; k < 2; ++k) {
          const int c = d * 32 + (q + k) * 8 + h * 4;
          uint2 u = *(const uint2*)(ur + c);
          ov[k].x = pk2(bflo(u.x) * (acc[d][(q + k) * 4] + bias), bfhi(u.x) * (acc[d][(q + k) * 4 + 1] + bias));
          ov[k].y = pk2(bflo(u.y) * (acc[d][(q + k) * 4 + 2] + bias), bfhi(u.y) * (acc[d][(q + k) * 4 + 3] + bias));
        }
        store_pair16(yr + d * 32 + q * 8, ov[0], ov[1], h);
      }
    __syncthreads();
  }
}

DI void grid_barrier(unsigned* ctr, unsigned& target) {
  __syncthreads();
  target += 1;
  if (threadIdx.x == 0) {
    __builtin_amdgcn_fence(__ATOMIC_RELEASE, "agent");
    unsigned* top = ctr;
    if ((gridDim.x & 7) == 0) {
      const unsigned gsz = gridDim.x >> 3;
      unsigned* gc = ctr + 32 * (1 + (blockIdx.x & 7));
      const unsigned old = __hip_atomic_fetch_add(gc, 1u, __ATOMIC_RELAXED, __HIP_MEMORY_SCOPE_AGENT);
      if (old + 1 == target * gsz) __hip_atomic_fetch_add(top, 1u, __ATOMIC_RELAXED, __HIP_MEMORY_SCOPE_AGENT);
      while (__hip_atomic_load(top, __ATOMIC_RELAXED, __HIP_MEMORY_SCOPE_AGENT) < target * 8u) __builtin_amdgcn_s_sleep(1);
    } else {
      __hip_atomic_fetch_add(top, 1u, __ATOMIC_RELAXED, __HIP_MEMORY_SCOPE_AGENT);
      while (__hip_atomic_load(top, __ATOMIC_RELAXED, __HIP_MEMORY_SCOPE_AGENT) < target * gridDim.x) __builtin_amdgcn_s_sleep(1);
    }
    __builtin_amdgcn_fence(__ATOMIC_ACQUIRE, "agent");
  }
  __syncthreads();
}

constexpr int SMEM_BYTES = 2 * G_STAGE;

__global__ void __launch_bounds__(512) fwd_megakernel(Params p) {
  cg::grid_group grid = cg::this_grid();
  __shared__ __attribute__((aligned(16))) char smem[SMEM_BYTES];
  char* ws = p.ws;
  u16* Wb = (u16*)(ws + OFF_W);
  float* cosA = (float*)(ws + OFF_ROPE);
  float* sinA = cosA + SEQ * 16;
  float* cosB = sinA + SEQ * 16;
  float* sinB = cosB + SEQ * 32;
  u16* memn = (u16*)(ws + OFF_MEMN);
  u16* memkv = (u16*)(ws + OFF_MEMKV);
  u16* H = (u16*)(ws + OFF_H);
  u16* Z = (u16*)(ws + OFF_Z);
  u16* Y = (u16*)(ws + OFF_Y);
  u16* QM = Y;
  u16* OM = (u16*)(ws + OFF_Y + 64 * MiB);
  u16* QA = (u16*)(ws + OFF_QA);
  u16* KA = (u16*)(ws + OFF_KA);
  u16* VA = (u16*)(ws + OFF_VA);
  float* X = p.out;
  unsigned* bar = (unsigned*)(ws + OFF_BAR);
  unsigned bar_target = 0;

  for (int l = 0; l < 2; ++l) {
    u16* wl = Wb + l * W_LAYER;
    transpose_phase(p.in[3] + (size_t)l * 1024 * 1568, 1024, 1568, wl + W_IN, false, smem);
    transpose_phase(p.in[5] + (size_t)l * 256 * 576, 256, 576, wl + W_UQ, false, smem);
    transpose_phase(p.in[7] + (size_t)l * 128 * 768, 128, 768, wl + W_UKV, false, smem);
    transpose_phase(p.in[14] + (size_t)l * 1024 * 1024, 1024, 1024, wl + W_OUT, false, smem);
    transpose_phase(p.in[17] + (size_t)l * 1024 * 512, 1024, 512, wl + W_MQ, false, smem);
    transpose_phase(p.in[18] + (size_t)l * 1024 * 1024, 1024, 1024, wl + W_MKV, false, smem);
    transpose_phase(p.in[19] + (size_t)l * 512 * 1024, 512, 1024, wl + W_MO, false, smem);
    transpose_phase(p.in[21] + (size_t)l * 1024 * 5632, 1024, 5632, wl + W_UP, true, smem);
    transpose_phase(p.in[24] + (size_t)l * 2816 * 1024, 2816, 1024, wl + W_DN, false, smem);
    const float* wsrc = p.in[11] + (size_t)l * 65536;
    for (int i = blockIdx.x * NTHR + tid_opaque(); i < 32768; i += gridDim.x * NTHR)
      *(unsigned*)(wl + W_S + i * 2) = pk2(wsrc[i * 2], wsrc[i * 2 + 1]);
    norm_rows_bf16(p.in[1], p.in[16] + l * DM, memn + (size_t)l * NMEM * DM, NMEM);
  }
  for (int i = blockIdx.x * NTHR + tid_opaque(); i < SEQ * 16; i += gridDim.x * NTHR) {
    int s = i >> 4, pi = i & 15;
    float pos = (pi < 8) ? (float)(s >> 6) : (float)(s & 63);
    float inv = powf(10000.f, -(float)(pi & 7) / 8.f);
    float ang = pos * inv;
    cosA[i] = cosf(ang); sinA[i] = sinf(ang);
  }
  for (int i = blockIdx.x * NTHR + tid_opaque(); i < SEQ * 32; i += gridDim.x * NTHR) {
    int s = i >> 5, pi = i & 31;
    float pos = (pi < 16) ? (float)(s >> 6) : (float)(s & 63);
    float inv = powf(10000.f, -(float)(pi & 15) / 16.f);
    float ang = pos * inv;
    cosB[i] = cosf(ang); sinB[i] = sinf(ang);
  }
  norm_rows_bf16(p.in[0], p.in[2], H, NTOK);
  grid.sync();

  for (int l = 0; l < 2; ++l) {
    GemmArgs g{};
    g.A = memn + (size_t)l * NMEM * DM; g.lda = DM; g.W = Wb + l * W_LAYER + W_MKV; g.ldw = DM;
    g.M = NMEM; g.N = 1024; g.K = 1024; g.epi = EPI_BF16; g.out = memkv + (size_t)l * NMEM * DM; g.ldo = DM; g.scale = 1.f;
    gemm_phase<false>(g, smem);
  }

  for (int l = 0; l < 2; ++l) {
    const u16* wl = Wb + l * W_LAYER;
    const float* xsrc = (l == 0) ? p.in[0] : X;
    {
      GemmArgs g{};
      g.A = H; g.lda = DM; g.W = wl + W_IN; g.ldw = DM; g.M = NTOK; g.N = DIN; g.K = DM; g.epi = EPI_BF16;
      g.out = Z; g.ldo = DIN; g.scale = 1.f;
      gemm_phase<false>(g, smem);
    }
    grid_barrier(bar, bar_target);
    {
      PostArgs a;
      a.z = Z; a.ka = KA;
      a.qn = p.in[4] + l * 256; a.kvn = p.in[6] + l * 128; a.gq = p.in[8] + l * 64; a.gk = p.in[9] + l * 64; a.gv = p.in[10] + l * 256;
      a.cosA = cosA; a.sinA = sinA; a.cosB = cosB; a.sinB = sinB;
      post_phase(a);
    }
    grid_barrier(bar, bar_target);
    {
      GemmArgs g{};
      g.A = Z; g.lda = DIN; g.W = wl + W_UQ; g.ldw = 256; g.M = NTOK; g.N = 576; g.K = 256; g.epi = EPI_QA;
      g.out = QA; g.ldo = 576; g.scale = 0.10206207261596575f * LOG2E; g.cosA = cosA; g.sinA = sinA;
      gemm_phase<false>(g, smem);
      GemmArgs g2{};
      g2.A = Z + 256; g2.lda = DIN; g2.W = wl + W_UKV; g2.ldw = 128; g2.M = NTOK; g2.N = 768; g2.K = 128; g2.epi = EPI_KVA;
      g2.out = KA; g2.out2 = VA;
      gemm_phase<false>(g2, smem);
      gmlp_phase(Z, wl + W_S, p.in[12] + l * 512, Y, smem);
    }
    grid_barrier(bar, bar_target);
    for (int jb = blockIdx.x; jb < 256; jb += gridDim.x) {
      const int b = jb & 7, qt = jb >> 3;
      const size_t tq = (size_t)b * SEQ + qt * 256, tk = (size_t)b * SEQ;
#pragma unroll 1
      for (int hd = 0; hd < 6; ++hd)
        attn_block_dma<96>(QA + tq * 576 + hd * 96, 576, KA + tk * 576 + hd * 96, 576, VA + tk * 384 + hd * 64, 384,
                           Y + tq * DM + hd * 64, DM, SEQ, smem);
#pragma unroll 1
      for (int hd = 0; hd < 6; ++hd) {
        const int kvh = hd / 3;
        attn_block_dma<64>(Z + tq * DIN + 416 + hd * 64, DIN, Z + tk * DIN + 800 + kvh * 64, DIN, Z + tk * DIN + 928 + kvh * 64, DIN,
                           Y + tq * DM + 384 + hd * 64, DM, SEQ, smem);
      }
      __builtin_amdgcn_fence(__ATOMIC_RELEASE, "workgroup");
      __syncthreads();
      __builtin_amdgcn_fence(__ATOMIC_ACQUIRE, "agent");
      outnorm_rows(Y, p.in[13] + l * DM, H, (int)tq);
    }
    grid_barrier(bar, bar_target);
    {
      GemmArgs g{};
      g.A = H; g.lda = DM; g.W = wl + W_OUT; g.ldw = DM; g.M = NTOK; g.N = DM; g.K = DM; g.epi = EPI_RESID;
      g.res = xsrc; g.outf = X;
      gemm_phase<false>(g, smem);
    }
    grid_barrier(bar, bar_target);
    norm_rows_bf16(X, p.in[15] + l * DM, H, NTOK);
    grid_barrier(bar, bar_target);
    {
      GemmArgs g{};
      g.A = H; g.lda = DM; g.W = wl + W_MQ; g.ldw = DM; g.M = NTOK; g.N = 512; g.K = DM; g.epi = EPI_BF16;
      g.out = QM; g.ldo = 512; g.scale = 0.08838834764831845f * LOG2E;
      gemm_phase<false>(g, smem);
    }
    grid_barrier(bar, bar_target);
    for (int j = blockIdx.x; j < 1024; j += gridDim.x) {
      const int x = j & 7, jj = j >> 3;
      const int pair = x + 8 * (jj >> 5), qt = jj & 31;
      const int b = pair >> 2, hd = pair & 3;
      const size_t tq = (size_t)b * SEQ + qt * 256;
      const u16* kv = memkv + (size_t)l * NMEM * DM + (size_t)b * 256 * DM;
      attn_block<128, 128>(QM + tq * 512 + hd * 128, 512, kv + hd * 128, DM, kv + 512 + hd * 128, DM, OM + tq * 512 + hd * 128, 512, 256, smem);
    }
    grid_barrier(bar, bar_target);
    {
      GemmArgs g{};
      g.A = OM; g.lda = 512; g.W = wl + W_MO; g.ldw = 512; g.M = NTOK; g.N = DM; g.K = 512; g.epi = EPI_RESID;
      g.res = X; g.outf = X;
      gemm_phase<false>(g, smem);
    }
    grid_barrier(bar, bar_target);
    norm_rows_bf16(X, p.in[20] + l * DM, H, NTOK);
    grid_barrier(bar, bar_target);
    {
      GemmArgs g{};
      g.A = H; g.lda = DM; g.W = wl + W_UP; g.ldw = DM; g.M = NTOK; g.N = 2 * DFF; g.K = DM; g.epi = 0;
      g.out = Z; g.convw = p.in[22] + (size_t)l * 3 * 2 * DFF; g.convb = p.in[23] + (size_t)l * 2 * DFF;
      gemm_phase<true>(g, smem);
    }
    grid_barrier(bar, bar_target);
    {
      GemmArgs g{};
      g.A = Z; g.lda = DFF; g.W = wl + W_DN; g.ldw = DFF; g.M = NTOK; g.N = DM; g.K = DFF; g.epi = EPI_RESID;
      g.res = X; g.outf = X;
      gemm_phase<false>(g, smem);
    }
    grid_barrier(bar, bar_target);
    if (l == 0) {
      norm_rows_bf16(X, p.in[2] + DM, H, NTOK);
    } else {
      final_norm_rows(X, p.in[25], NTOK);
    }
    if (l == 0) grid_barrier(bar, bar_target);
  }
}

extern "C" void kernel_launch(void* const* d_in, const int* in_sizes, int n_in, void* d_out, int out_size, void* d_ws, size_t ws_size,
                              hipStream_t stream) {
  static int grid_blocks = 0;
  if (!grid_blocks) {
    int dev = 0, cus = 0, per_cu = 0;
    hipGetDevice(&dev);
    hipDeviceGetAttribute(&cus, hipDeviceAttributeMultiprocessorCount, dev);
    hipOccupancyMaxActiveBlocksPerMultiprocessor(&per_cu, fwd_megakernel, NTHR, 0);
    if (per_cu > 1) per_cu = 1;
    if (per_cu < 1) per_cu = 1;
    grid_blocks = cus * per_cu;
  }
  Params p{};
  for (int i = 0; i < 26; ++i) p.in[i] = (const float*)d_in[i];
  p.out = (float*)d_out;
  p.ws = (char*)d_ws;
  hipMemsetAsync((char*)d_ws + OFF_BAR, 0, 2048, stream);
  void* args[] = {&p};
  hipError_t e = hipLaunchCooperativeKernel((void*)fwd_megakernel, dim3(grid_blocks), dim3(NTHR), args, 0, stream);
  if (e != hipSuccess) fprintf(stderr, "cooperative launch failed: %s (grid %d)\n", hipGetErrorString(e), grid_blocks);
}
```

```cpp
#include <hip/hip_runtime.h>
#include <hip/hip_cooperative_groups.h>
#include <cstdio>
namespace cg = cooperative_groups;

typedef unsigned short u16;
typedef __attribute__((ext_vector_type(8))) short bf16x8;
typedef __attribute__((ext_vector_type(4))) short s16x4;
typedef __attribute__((ext_vector_type(16))) float f32x16;
typedef __attribute__((ext_vector_type(2))) __bf16 bf2_t;
typedef __attribute__((ext_vector_type(2))) float f2_t;
typedef __attribute__((address_space(3))) s16x4 lds_s16x4;
typedef __attribute__((ext_vector_type(4))) unsigned u32x4;

#define DI __device__ __forceinline__
#define MFMA(a, b, c) __builtin_amdgcn_mfma_f32_32x32x16_bf16((a), (b), (c), 0, 0, 0)

constexpr int NTOK = 65536, SEQ = 8192, NB = 8, DM = 1024, DIN = 1568, DFF = 2816, NMEM = 2048;
constexpr float LOG2E = 1.4426950408889634f;
constexpr float EPSF = 1e-6f;
constexpr int NTHR = 512, NWAVE = 8;

constexpr size_t MiB = 1ull << 20;
constexpr size_t W_IN = 0, W_UQ = W_IN + 1568ull * 1024, W_UKV = W_UQ + 576ull * 256, W_OUT = W_UKV + 768ull * 128,
                 W_MQ = W_OUT + 1024ull * 1024, W_MKV = W_MQ + 512ull * 1024, W_MO = W_MKV + 1024ull * 1024,
                 W_UP = W_MO + 1024ull * 512, W_DN = W_UP + 5632ull * 1024, W_S = W_DN + 1024ull * 2816,
                 W_LAYER = W_S + 4ull * 128 * 128;
constexpr size_t OFF_W = 0;
constexpr size_t OFF_ROPE = 56 * MiB;
constexpr size_t OFF_MEMN = 60 * MiB;
constexpr size_t OFF_MEMKV = 68 * MiB;
constexpr size_t OFF_H = 76 * MiB;
constexpr size_t OFF_Z = 204 * MiB;
constexpr size_t OFF_Y = 556 * MiB;
constexpr size_t OFF_QA = 684 * MiB;
constexpr size_t OFF_KA = 756 * MiB;
constexpr size_t OFF_VA = 828 * MiB;
constexpr size_t OFF_BAR = 940 * MiB;

struct Params {
  const float* in[26];
  float* out;
  char* ws;
};

DI int tid_opaque() { int t = threadIdx.x; asm volatile("" : "+v"(t)); return t; }
DI void gload16(u32x4& r, const void* p) { asm volatile("global_load_dwordx4 %0, %1, off" : "=v"(r) : "v"(p) : "memory"); }
DI void glds16(const void* gsrc, unsigned lds_dst) {
  unsigned keep;
  asm volatile("s_mov_b32 %0, m0\n\ts_mov_b32 m0, %2\n\ts_nop 0\n\tglobal_load_lds_dwordx4 %1, off\n\ts_mov_b32 m0, %0" : "=&s"(keep) : "v"(gsrc), "s"(lds_dst) : "memory");
}
#define VM_WAIT(n) asm volatile("s_waitcnt vmcnt(" #n ")" ::: "memory")
#define TIE(x) asm volatile("" : "+v"(x))
DI unsigned pk2(float a, float b) { f2_t v = {a, b}; bf2_t r = __builtin_convertvector(v, bf2_t); return __builtin_bit_cast(unsigned, r); }
DI float bflo(unsigned u) { return __uint_as_float(u << 16); }
DI float bfhi(unsigned u) { return __uint_as_float(u & 0xffff0000u); }
DI float wave_sum(float v) {
#pragma unroll
  for (int o = 32; o; o >>= 1) v += __shfl_xor(v, o);
  return v;
}
DI float half_sum(float v) {
#pragma unroll
  for (int o = 16; o; o >>= 1) v += __shfl_xor(v, o);
  return v;
}
DI float xhalf(float v, int h) {
  auto r = __builtin_amdgcn_permlane32_swap(__float_as_uint(v), __float_as_uint(v), false, false);
  return __uint_as_float(h ? r[0] : r[1]);
}
DI float dpp_xor1(float v) {
  return __uint_as_float(__builtin_amdgcn_update_dpp(0u, __float_as_uint(v), 0xB1, 0xf, 0xf, true));
}
DI void store_pair16(u16* p8k, uint2 a, uint2 b, int h) {
  auto r0 = __builtin_amdgcn_permlane32_swap(a.x, b.x, false, false);
  auto r1 = __builtin_amdgcn_permlane32_swap(a.y, b.y, false, false);
  uint4 v = {r0[0], r1[0], r0[1], r1[1]};
  *(uint4*)(p8k + (h ? 8 : 0)) = v;
}
DI float gelu_tanh(float x) {
  float y = 0.7978845608028654f * (x + 0.044715f * x * x * x);
  float e = __expf(2.f * y);
  float th = 1.f - 2.f / (1.f + e);
  return 0.5f * x * (1.f + th);
}

DI void transpose_phase(const float* __restrict__ in, int K, int N, u16* __restrict__ out, bool ffn_perm, char* smem) {
  const int tt = tid_opaque();
  const int half = tt >> 8, t = tt & 255;
  float(*tile)[33] = (float(*)[33])(smem + half * (64 * 33 * 4));
  const int nkt = K / 64, nnt = N / 32, njobs = nkt * nnt;
  for (int jp = blockIdx.x; jp * 2 < njobs; jp += gridDim.x) {
    const int job = jp * 2 + half;
    const bool ok = job < njobs;
    const int kt = job % nkt, ntile = job / nkt;
    const int kbase = kt * 64, nbase = ntile * 32;
    const int src = ffn_perm ? ((ntile & 1) * DFF + (ntile >> 1) * 32) : nbase;
    if (ok) {
#pragma unroll
      for (int it = 0; it < 2; ++it) {
        const int k = it * 32 + (t >> 3), n4 = (t & 7) * 4;
        const float4 v = *(const float4*)(in + (size_t)(kbase + k) * N + src + n4);
        tile[k][n4] = v.x; tile[k][n4 + 1] = v.y; tile[k][n4 + 2] = v.z; tile[k][n4 + 3] = v.w;
      }
    }
    __syncthreads();
    if (ok) {
      int n = t >> 3, kq = t & 7;
      float v[8];
#pragma unroll
      for (int j = 0; j < 8; ++j) v[j] = tile[kq * 8 + j][n];
      uint4 r = {pk2(v[0], v[1]), pk2(v[2], v[3]), pk2(v[4], v[5]), pk2(v[6], v[7])};
      *(uint4*)(out + (size_t)(nbase + n) * K + kbase + kq * 8) = r;
    }
    __syncthreads();
  }
}

DI void norm_rows_bf16(const float* __restrict__ x, const float* __restrict__ gain, u16* __restrict__ out, int rows) {
  const int t = tid_opaque();
  const int lane = t & 63;
  const int wid = blockIdx.x * NWAVE + (t >> 6), nw = gridDim.x * NWAVE;
  float4 g[4];
#pragma unroll
  for (int j = 0; j < 4; ++j) g[j] = *(const float4*)(gain + j * 256 + lane * 4);
  for (int r = wid; r < rows; r += nw) {
    const float* xr = x + (size_t)r * DM;
    float4 v[4];
    float ss = 0.f;
#pragma unroll
    for (int j = 0; j < 4; ++j) {
      v[j] = *(const float4*)(xr + j * 256 + lane * 4);
      ss += v[j].x * v[j].x + v[j].y * v[j].y + v[j].z * v[j].z + v[j].w * v[j].w;
    }
    ss = wave_sum(ss);
    const float rs = rsqrtf(ss * (1.f / DM) + EPSF);
#pragma unroll
    for (int j = 0; j < 4; ++j) {
      uint2 o = {pk2(v[j].x * rs * g[j].x, v[j].y * rs * g[j].y), pk2(v[j].z * rs * g[j].z, v[j].w * rs * g[j].w)};
      *(uint2*)(out + (size_t)r * DM + j * 256 + lane * 4) = o;
    }
  }
}

DI void final_norm_rows(float* __restrict__ x, const float* __restrict__ gain, int rows) {
  const int t = tid_opaque();
  const int lane = t & 63;
  const int wid = blockIdx.x * NWAVE + (t >> 6), nw = gridDim.x * NWAVE;
  float4 g[4];
#pragma unroll
  for (int j = 0; j < 4; ++j) g[j] = *(const float4*)(gain + j * 256 + lane * 4);
  for (int r = wid; r < rows; r += nw) {
    float* xr = x + (size_t)r * DM;
    float4 v[4];
    float ss = 0.f;
#pragma unroll
    for (int j = 0; j < 4; ++j) {
      v[j] = *(const float4*)(xr + j * 256 + lane * 4);
      ss += v[j].x * v[j].x + v[j].y * v[j].y + v[j].z * v[j].z + v[j].w * v[j].w;
    }
    ss = wave_sum(ss);
    const float rs = rsqrtf(ss * (1.f / DM) + EPSF);
#pragma unroll
    for (int j = 0; j < 4; ++j) {
      float4 o = {v[j].x * rs * g[j].x, v[j].y * rs * g[j].y, v[j].z * rs * g[j].z, v[j].w * rs * g[j].w};
      *(float4*)(xr + j * 256 + lane * 4) = o;
    }
  }
}

struct PostArgs {
  u16* z; u16* ka;
  const float *qn, *kvn, *gq, *gk, *gv;
  const float *cosA, *sinA, *cosB, *sinB;
};
DI void post_phase(const PostArgs& a) {
  const int t = tid_opaque();
  const int lane = t & 63, l32 = lane & 31, hh = lane >> 5;
  const int wid = blockIdx.x * NWAVE + (t >> 6), nw = gridDim.x * NWAVE;
  const float qscale = 0.125f * LOG2E;
  for (int tok = wid; tok < NTOK; tok += nw) {
    u16* zr = a.z + (size_t)tok * DIN;
    const int s = tok & (SEQ - 1);
    uint2 cq = *(const uint2*)(zr + lane * 4);
    unsigned ckv = *(const unsigned*)(zr + 256 + lane * 2);
    unsigned kr = *(const unsigned*)(zr + 384 + (lane & 15) * 2);
    unsigned gq[3];
#pragma unroll
    for (int it = 0; it < 3; ++it) gq[it] = *(const unsigned*)(zr + 416 + (it * 2 + hh) * 64 + l32 * 2);
    unsigned gk = *(const unsigned*)(zr + 800 + hh * 64 + l32 * 2);
    uint4 gm = *(const uint4*)(zr + 1056 + lane * 8);
    {
      float v0 = bflo(cq.x), v1 = bfhi(cq.x), v2 = bflo(cq.y), v3 = bfhi(cq.y);
      float ss = wave_sum(v0 * v0 + v1 * v1 + v2 * v2 + v3 * v3);
      float rs = rsqrtf(ss * (1.f / 256.f) + EPSF);
      float4 g = *(const float4*)(a.qn + lane * 4);
      uint2 o = {pk2(v0 * rs * g.x, v1 * rs * g.y), pk2(v2 * rs * g.z, v3 * rs * g.w)};
      *(uint2*)(zr + lane * 4) = o;
    }
    {
      float v0 = bflo(ckv), v1 = bfhi(ckv);
      float ss = wave_sum(v0 * v0 + v1 * v1);
      float rs = rsqrtf(ss * (1.f / 128.f) + EPSF);
      float2 g = *(const float2*)(a.kvn + lane * 2);
      *(unsigned*)(zr + 256 + lane * 2) = pk2(v0 * rs * g.x, v1 * rs * g.y);
    }
    if (lane < 16) {
      float x0 = bflo(kr), x1 = bfhi(kr);
      float c = a.cosA[s * 16 + lane], sn = a.sinA[s * 16 + lane];
      unsigned o = pk2(x0 * c - x1 * sn, x0 * sn + x1 * c);
#pragma unroll
      for (int hd = 0; hd < 6; ++hd) *(unsigned*)(a.ka + (size_t)tok * 576 + hd * 96 + 64 + lane * 2) = o;
    }
    {
      float2 g = *(const float2*)(a.gq + l32 * 2);
      float c = a.cosB[s * 32 + l32], sn = a.sinB[s * 32 + l32];
#pragma unroll
      for (int it = 0; it < 3; ++it) {
        float v0 = bflo(gq[it]), v1 = bfhi(gq[it]);
        float ss = half_sum(v0 * v0 + v1 * v1);
        float rs = rsqrtf(ss * (1.f / 64.f) + EPSF);
        v0 *= rs * g.x; v1 *= rs * g.y;
        *(unsigned*)(zr + 416 + (it * 2 + hh) * 64 + l32 * 2) = pk2((v0 * c - v1 * sn) * qscale, (v0 * sn + v1 * c) * qscale);
      }
      float2 g2 = *(const float2*)(a.gk + l32 * 2);
      float v0 = bflo(gk), v1 = bfhi(gk);
      float ss = half_sum(v0 * v0 + v1 * v1);
      float rs = rsqrtf(ss * (1.f / 64.f) + EPSF);
      v0 *= rs * g2.x; v1 *= rs * g2.y;
      *(unsigned*)(zr + 800 + hh * 64 + l32 * 2) = pk2(v0 * c - v1 * sn, v0 * sn + v1 * c);
    }
    {
      float v[8] = {bflo(gm.x), bfhi(gm.x), bflo(gm.y), bfhi(gm.y), bflo(gm.z), bfhi(gm.z), bflo(gm.w), bfhi(gm.w)};
      float ss = 0.f;
#pragma unroll
      for (int j = 0; j < 8; ++j) { v[j] = gelu_tanh(v[j]); ss += v[j] * v[j]; }
      ss = hh ? ss : 0.f;
      ss = wave_sum(ss);
      float rs = rsqrtf(ss * (1.f / 256.f) + EPSF);
      if (hh) {
        float4 g0 = *(const float4*)(a.gv + l32 * 8), g1 = *(const float4*)(a.gv + l32 * 8 + 4);
        v[0] *= rs * g0.x; v[1] *= rs * g0.y; v[2] *= rs * g0.z; v[3] *= rs * g0.w;
        v[4] *= rs * g1.x; v[5] *= rs * g1.y; v[6] *= rs * g1.z; v[7] *= rs * g1.w;
      }
      uint4 o = {pk2(v[0], v[1]), pk2(v[2], v[3]), pk2(v[4], v[5]), pk2(v[6], v[7])};
      *(uint4*)(zr + 1056 + lane * 8) = o;
    }
  }
}

DI void outnorm_rows(const u16* __restrict__ y, const float* __restrict__ gain, u16* __restrict__ out, int row0) {
  const int t = tid_opaque();
  const int lane = t & 63;
  const int rbeg = row0 + (t >> 6) * 32;
  const int seg = lane < 24 ? 0 : (lane < 48 ? 1 : 2);
  float g[16];
#pragma unroll
  for (int j = 0; j < 4; ++j) {
    float4 t4 = *(const float4*)(gain + lane * 16 + j * 4);
    g[j * 4] = t4.x; g[j * 4 + 1] = t4.y; g[j * 4 + 2] = t4.z; g[j * 4 + 3] = t4.w;
  }
  for (int r = rbeg; r < rbeg + 32; ++r) {
    const u16* yr = y + (size_t)r * DM + lane * 16;
    uint4 a = *(const uint4*)yr, b = *(const uint4*)(yr + 8);
    float v[16] = {bflo(a.x), bfhi(a.x), bflo(a.y), bfhi(a.y), bflo(a.z), bfhi(a.z), bflo(a.w), bfhi(a.w),
                   bflo(b.x), bfhi(b.x), bflo(b.y), bfhi(b.y), bflo(b.z), bfhi(b.z), bflo(b.w), bfhi(b.w)};
    float ss = 0.f;
#pragma unroll
    for (int j = 0; j < 16; ++j) ss += v[j] * v[j];
    float s0 = wave_sum(seg == 0 ? ss : 0.f), s1 = wave_sum(seg == 1 ? ss : 0.f), s2 = wave_sum(seg == 2 ? ss : 0.f);
    float rs = seg == 0 ? rsqrtf(s0 * (1.f / 384.f) + EPSF) : (seg == 1 ? rsqrtf(s1 * (1.f / 384.f) + EPSF) : rsqrtf(s2 * (1.f / 256.f) + EPSF));
#pragma unroll
    for (int j = 0; j < 16; ++j) v[j] *= rs * g[j];
    uint4 o0 = {pk2(v[0], v[1]), pk2(v[2], v[3]), pk2(v[4], v[5]), pk2(v[6], v[7])};
    uint4 o1 = {pk2(v[8], v[9]), pk2(v[10], v[11]), pk2(v[12], v[13]), pk2(v[14], v[15])};
    u16* orow = out + (size_t)r * DM + lane * 16;
    *(uint4*)orow = o0; *(uint4*)(orow + 8) = o1;
  }
}

enum { EPI_BF16 = 0, EPI_QA = 1, EPI_KVA = 2, EPI_RESID = 3 };
struct GemmArgs {
  const u16* A; int lda;
  const u16* W; int ldw;
  int M, N, K, epi;
  u16* out; int ldo; float scale;
  u16* out2;
  const float* res; float* outf;
  const float *cosA, *sinA;
  const float *convw, *convb;
};
constexpr int G_ROW = 128;
constexpr int G_STAGE = (256 + 256) * G_ROW;
constexpr int FFN_MT_PER_SEQ = 33;

template <bool FFN>
DI void gemm_tile(const GemmArgs& g, int mt, int nt, char* smem) {
  const int t = tid_opaque(), lane = t & 63, w = t >> 6, l32 = lane & 31, h = lane >> 5;
  const int wm_ = w >> 2, wn_ = w & 3;
  const int m0 = mt * 256, n0 = nt * 256;
  const int prw = lane >> 3, pslot = lane & 7;
  const u16* asrc[4]; const u16* wsrc[4];
#pragma unroll
  for (int i = 0; i < 4; ++i) {
    const int r = (w * 4 + i) * 8 + prw;
    const int gr = pslot ^ ((r >> 1) & 7);
    size_t grow;
    if (FFN) {
      const int b = mt / FFN_MT_PER_SEQ, ti = mt % FFN_MT_PER_SEQ;
      int tok = ti * 252 - 1 + r - (r >= 128 ? 2 : 0);
      tok = tok < 0 ? 0 : (tok >= SEQ ? SEQ - 1 : tok);
      grow = (size_t)b * SEQ + tok;
    } else grow = (size_t)m0 + r;
    asrc[i] = g.A + grow * g.lda + gr * 8;
    int n = n0 + r; n = n < g.N ? n : 0;
    wsrc[i] = g.W + (size_t)n * g.ldw + gr * 8;
  }
  int nv = (g.N - (n0 + wn_ * 64)) >> 5;
  nv = nv < 0 ? 0 : (nv > 2 ? 2 : nv);
  nv = __builtin_amdgcn_readfirstlane(nv);

  f32x16 acc[4][2];
#pragma unroll
  for (int mi = 0; mi < 4; ++mi)
#pragma unroll
    for (int ni = 0; ni < 2; ++ni)
#pragma unroll
      for (int r = 0; r < 16; ++r) acc[mi][ni][r] = 0.f;

  const int nk = g.K >> 6;
  const unsigned lds_w = __builtin_amdgcn_readfirstlane((unsigned)(size_t)smem + (unsigned)(w * 4096));
  const int sw = (l32 >> 1) & 7;
  const char* const fr_a = smem + (wm_ * 128 + l32) * G_ROW;
  const char* const fr_w = smem + 256 * G_ROW + (wn_ * 64 + l32) * G_ROW;

#define G_DMA(kt, stg)                                                          \
  {                                                                             \
    _Pragma("unroll") for (int i = 0; i < 4; ++i) {                             \
      glds16(asrc[i] + (kt) * 64, lds_w + (stg) * G_STAGE + i * 1024);          \
      glds16(wsrc[i] + (kt) * 64, lds_w + (stg) * G_STAGE + 256 * G_ROW + i * 1024); \
    }                                                                           \
  }
#define G_COMPUTE_N(stg, NIV)                                                   \
  {                                                                             \
    _Pragma("unroll") for (int k2 = 0; k2 < 4; k2 += 2) {                       \
      bf16x8 af[2][4], wf[2][2];                                                \
      _Pragma("unroll") for (int u = 0; u < 2; ++u) {                           \
        const int ko = (((k2 + u) * 2 + h) ^ sw) * 16;                          \
        wf[u][0] = *(const bf16x8*)(fr_w + (stg) * G_STAGE + ko);               \
        _Pragma("unroll") for (int mi = 0; mi < 4; ++mi) af[u][mi] = *(const bf16x8*)(fr_a + (stg) * G_STAGE + mi * 32 * G_ROW + ko); \
        if (NIV > 1) wf[u][1] = *(const bf16x8*)(fr_w + (stg) * G_STAGE + 32 * G_ROW + ko);  \
      }                                                                         \
      __builtin_amdgcn_sched_barrier(0);                                        \
      _Pragma("unroll") for (int u = 0; u < 2; ++u) {                           \
        _Pragma("unroll") for (int ni = 0; ni < NIV; ++ni) {                    \
          _Pragma("unroll") for (int mi = 0; mi < 4; ++mi) {                    \
            if (FFN) acc[mi][ni] = MFMA(af[u][mi], wf[u][ni], acc[mi][ni]);     \
            else     acc[mi][ni] = MFMA(wf[u][ni], af[u][mi], acc[mi][ni]);     \
          }                                                                     \
        }                                                                       \
      }                                                                         \
      __builtin_amdgcn_sched_barrier(0);                                        \
    }                                                                           \
  }

  __builtin_amdgcn_s_waitcnt(0x0F70);
  G_DMA(0, 0);
  VM_WAIT(0);
  __syncthreads();
#define G_KLOOP(NIV)                                                            \
  for (int kt = 0; kt < nk; kt += 2) {                                          \
    G_DMA(kt + 1, 1);                                 \
    if (NIV > 0) G_COMPUTE_N(0, (NIV > 0 ? NIV : 1));                           \
    VM_WAIT(0);                                                                 \
    __syncthreads();                                                            \
    if (kt + 2 < nk) G_DMA(kt + 2, 0);                                          \
    if (NIV > 0) G_COMPUTE_N(1, (NIV > 0 ? NIV : 1));                           \
    VM_WAIT(0);                                                                 \
    __syncthreads();                                                            \
  }
  if (nv == 2) { G_KLOOP(2) } else if (nv == 1) { G_KLOOP(1) } else { G_KLOOP(0) }
#undef G_KLOOP
#undef G_COMPUTE_N
#undef G_DMA

  if (FFN) {
    const int ch = (nt * 4 + wn_) * 32 + l32;
    const float* cw = g.convw;
    const float gw0 = cw[ch], gw1 = cw[2 * DFF + ch], gw2 = cw[4 * DFF + ch], gb = g.convb[ch];
    const float vw0 = cw[DFF + ch], vw1 = cw[3 * DFF + ch], vw2 = cw[5 * DFF + ch], vb = g.convb[DFF + ch];
    const int b = mt / FFN_MT_PER_SEQ, ti = mt % FFN_MT_PER_SEQ;
    const int tok0 = ti * 252 - 1 + wm_ * 126;
#pragma unroll
    for (int mi = 0; mi < 4; ++mi)
#pragma unroll
      for (int q = 0; q < 4; ++q)
#pragma unroll
        for (int e = 0; e < 4; ++e) {
          const bool okr = (unsigned)(tok0 + mi * 32 + q * 8 + h * 4 + e) < (unsigned)SEQ;
          acc[mi][0][q * 4 + e] = okr ? acc[mi][0][q * 4 + e] : 0.f;
          acc[mi][1][q * 4 + e] = okr ? acc[mi][1][q * 4 + e] : 0.f;
        }
    float pprev0 = 0.f, pprev1 = 0.f;
    float ncur0 = xhalf(acc[0][0][0], h), ncur1 = xhalf(acc[0][1][0], h);
#pragma unroll
    for (int gi = 0; gi < 16; ++gi) {
      const int mi = gi >> 2, q = gi & 3;
      float a0 = acc[mi][0][q * 4], a1 = acc[mi][0][q * 4 + 1], a2 = acc[mi][0][q * 4 + 2], a3 = acc[mi][0][q * 4 + 3];
      float b0 = acc[mi][1][q * 4], b1 = acc[mi][1][q * 4 + 1], b2 = acc[mi][1][q * 4 + 2], b3 = acc[mi][1][q * 4 + 3];
      float pg0 = xhalf(a3, h), pg1 = xhalf(b3, h);
      float nn0 = 0.f, nn1 = 0.f;
      if (gi < 15) {
        const int mi2 = (gi + 1) >> 2, q2 = (gi + 1) & 3;
        nn0 = xhalf(acc[mi2][0][q2 * 4], h);
        nn1 = xhalf(acc[mi2][1][q2 * 4], h);
      }
      float pa = h ? pg0 : pprev0, pb = h ? pg1 : pprev1;
      float na = h ? nn0 : ncur0, nb = h ? nn1 : ncur1;
      pprev0 = pg0; pprev1 = pg1; ncur0 = nn0; ncur1 = nn1;
      float cg[4], cv[4];
      cg[0] = gw0 * pa + gw1 * a0 + gw2 * a1 + gb;
      cg[1] = gw0 * a0 + gw1 * a1 + gw2 * a2 + gb;
      cg[2] = gw0 * a1 + gw1 * a2 + gw2 * a3 + gb;
      cg[3] = gw0 * a2 + gw1 * a3 + gw2 * na + gb;
      cv[0] = vw0 * pb + vw1 * b0 + vw2 * b1 + vb;
      cv[1] = vw0 * b0 + vw1 * b1 + vw2 * b2 + vb;
      cv[2] = vw0 * b1 + vw1 * b2 + vw2 * b3 + vb;
      cv[3] = vw0 * b2 + vw1 * b3 + vw2 * nb + vb;
      float sv[4];
#pragma unroll
      for (int e = 0; e < 4; ++e) {
        const float gt = cg[e];
        sv[e] = gt * __builtin_amdgcn_rcpf(1.f + __expf(-gt)) * cv[e];
      }
      {
        const int odd = l32 & 1;
        const float r0 = dpp_xor1(odd ? sv[0] : sv[2]), r1 = dpp_xor1(odd ? sv[1] : sv[3]);
        const unsigned w0 = odd ? pk2(r0, sv[2]) : pk2(sv[0], r0);
        const unsigned w1 = odd ? pk2(r1, sv[3]) : pk2(sv[1], r1);
        const int rowb = wm_ * 128 + mi * 32 + q * 8 + h * 4 + odd * 2;
        char* tp = smem + rowb * 272 + (wn_ * 32 + (l32 & ~1)) * 2;
        *(unsigned*)tp = w0;
        *(unsigned*)(tp + 272) = w1;
      }
      __builtin_amdgcn_sched_barrier(0);
    }
    __syncthreads();
    {
      const int chb = nt * 128;
#pragma unroll
      for (int i = 0; i < 8; ++i) {
        const int c = t + i * NTHR, row = c >> 4, cc = c & 15;
        const int lr = row & 127;
        const int tok = ti * 252 - 1 + (row >> 7) * 126 + lr;
        const uint4 v = *(const uint4*)(smem + row * 272 + cc * 16);
        if (lr >= 1 && lr <= 126 && tok < SEQ) *(uint4*)(g.out + (size_t)(b * SEQ + tok) * DFF + chb + cc * 8) = v;
      }
    }
    __syncthreads();
  } else {
#pragma unroll
    for (int mi = 0; mi < 4; ++mi) {
      const int m = m0 + wm_ * 128 + mi * 32 + l32;
#pragma unroll
      for (int ni = 0; ni < 2; ++ni) {
        if (ni < nv && g.epi == EPI_KVA) {
#pragma unroll
          for (int q = 0; q < 4; q += 2) {
            const int nb = n0 + wn_ * 64 + ni * 32 + q * 8;
            const int hd = nb >> 7, within = nb & 127;
            uint2 a = {pk2(acc[mi][ni][q * 4], acc[mi][ni][q * 4 + 1]), pk2(acc[mi][ni][q * 4 + 2], acc[mi][ni][q * 4 + 3])};
            uint2 b = {pk2(acc[mi][ni][q * 4 + 4], acc[mi][ni][q * 4 + 5]), pk2(acc[mi][ni][q * 4 + 6], acc[mi][ni][q * 4 + 7])};
            u16* dst = (within < 64) ? g.out + (size_t)m * 576 + hd * 96 + within : g.out2 + (size_t)m * 384 + hd * 64 + within - 64;
            store_pair16(dst, a, b, h);
          }
        } else if (ni < nv && (g.epi == EPI_BF16 || g.epi == EPI_QA)) {
          uint2 pkd[4];
#pragma unroll
          for (int q = 0; q < 4; ++q) {
            const int n = n0 + wn_ * 64 + ni * 32 + q * 8 + h * 4;
            float v0 = acc[mi][ni][q * 4], v1 = acc[mi][ni][q * 4 + 1], v2 = acc[mi][ni][q * 4 + 2], v3 = acc[mi][ni][q * 4 + 3];
            if (g.epi == EPI_QA) {
              const int within = n % 96;
              if (within >= 64) {
                const int s = m & (SEQ - 1), pi = (within - 64) >> 1;
                float c0 = g.cosA[s * 16 + pi], s0 = g.sinA[s * 16 + pi], c1 = g.cosA[s * 16 + pi + 1], s1 = g.sinA[s * 16 + pi + 1];
                float t0 = v0 * c0 - v1 * s0, t1 = v0 * s0 + v1 * c0, t2 = v2 * c1 - v3 * s1, t3 = v2 * s1 + v3 * c1;
                v0 = t0; v1 = t1; v2 = t2; v3 = t3;
              }
            }
            pkd[q].x = pk2(v0 * g.scale, v1 * g.scale); pkd[q].y = pk2(v2 * g.scale, v3 * g.scale);
          }
          u16* rowp = g.out + (size_t)m * g.ldo + n0 + wn_ * 64 + ni * 32;
          store_pair16(rowp, pkd[0], pkd[1], h);
          store_pair16(rowp + 16, pkd[2], pkd[3], h);
        } else if (ni < nv) {
#pragma unroll
          for (int q = 0; q < 4; ++q) {
            const int n = n0 + wn_ * 64 + ni * 32 + q * 8 + h * 4;
            float v0 = acc[mi][ni][q * 4], v1 = acc[mi][ni][q * 4 + 1], v2 = acc[mi][ni][q * 4 + 2], v3 = acc[mi][ni][q * 4 + 3];
            if (g.epi == EPI_QA) {
              const int within = n % 96;
              if (within >= 64) {
                const int s = m & (SEQ - 1), pi = (within - 64) >> 1;
                float c0 = g.cosA[s * 16 + pi], s0 = g.sinA[s * 16 + pi], c1 = g.cosA[s * 16 + pi + 1], s1 = g.sinA[s * 16 + pi + 1];
                float t0 = v0 * c0 - v1 * s0, t1 = v0 * s0 + v1 * c0, t2 = v2 * c1 - v3 * s1, t3 = v2 * s1 + v3 * c1;
                v0 = t0; v1 = t1; v2 = t2; v3 = t3;
              }
              uint2 o = {pk2(v0 * g.scale, v1 * g.scale), pk2(v2 * g.scale, v3 * g.scale)};
              *(uint2*)(g.out + (size_t)m * 576 + n) = o;
            } else if (g.epi == EPI_KVA) {
              const int hd = n >> 7, within = n & 127;
              uint2 o = {pk2(v0, v1), pk2(v2, v3)};
              if (within < 64) *(uint2*)(g.out + (size_t)m * 576 + hd * 96 + within) = o;
              else *(uint2*)(g.out2 + (size_t)m * 384 + hd * 64 + within - 64) = o;
            } else {
              float4 r = *(const float4*)(g.res + (size_t)m * DM + n);
              float4 o = {r.x + v0, r.y + v1, r.z + v2, r.w + v3};
              *(float4*)(g.outf + (size_t)m * DM + n) = o;
            }
          }
        }
        __builtin_amdgcn_sched_barrier(0);
      }
    }
  }
}

template <bool FFN>
DI void gemm_phase(const GemmArgs& g, char* smem) {
  const int MT = FFN ? NB * FFN_MT_PER_SEQ : g.M / 256;
  const int NT = (g.N + 255) / 256;
  const int njobs = MT * NT;
  const int MTx = MT >> 3;
  const int ngf = NT >> 2, jfull = MTx * 4;
  for (int j = blockIdx.x; j < njobs; j += gridDim.x) {
    const int x = j & 7, jj = j >> 3;
    int ng, rem, gn;
    if (jj < ngf * jfull) { ng = jj / jfull; rem = jj - ng * jfull; gn = 4; }
    else { ng = ngf; rem = jj - ngf * jfull; gn = NT & 3; }
    const int ml = rem / gn, nin = rem - ml * gn;
    const int mt = x + 8 * ml, nt = ng * 4 + nin;
    gemm_tile<FFN>(g, mt, nt, smem);
  }
}

DI float max3f(float a, float b, float c) { return fmaxf(fmaxf(a, b), c); }
DI float xhalf_max(float v) {
  auto r = __builtin_amdgcn_permlane32_swap(__float_as_uint(v), __float_as_uint(v), false, false);
  return fmaxf(__uint_as_float(r[0]), __uint_as_float(r[1]));
}
DI int prow(int i) { return (i & ~12) | ((i & 4) << 1) | ((i & 8) >> 1); }

template <int DK, int DV>
DI void attn_block(const u16* __restrict__ Q, int ldq, const u16* __restrict__ K, int ldk, const u16* __restrict__ V, int ldv,
                   u16* __restrict__ O, int ldo, int T, char* smem) {
  constexpr int KS = DK * 2 + 16, VS = DV * 2 + 64;
  constexpr int TK = (DK <= 96 && DV <= 64) ? 128 : 64;
  constexpr int NKB = TK / 32, NC = TK / 16;
  constexpr int KT = TK * KS, STG = KT + TK * VS;
  constexpr int KCH = DK / 8, VCH = DV / 8;
  constexpr int NK = (TK * KCH + NTHR - 1) / NTHR, NV = (TK * VCH + NTHR - 1) / NTHR;
  const int t = tid_opaque(), lane = t & 63, w = t >> 6, l32 = lane & 31, h = lane >> 5;

  bf16x8 qf[DK / 16];
#pragma unroll
  for (int kc = 0; kc < DK / 16; ++kc) qf[kc] = *(const bf16x8*)(Q + (size_t)(w * 32 + l32) * ldq + kc * 16 + h * 8);
#pragma unroll
  for (int kc = 0; kc < DK / 16; ++kc) asm volatile("" ::"v"(qf[kc]));

  f32x16 o[DV / 32];
#pragma unroll
  for (int d = 0; d < DV / 32; ++d)
#pragma unroll
    for (int r = 0; r < 16; ++r) o[d][r] = 0.f;
  float mref = 0.f;
  f32x16 negm;
#pragma unroll
  for (int r = 0; r < 16; ++r) negm[r] = 0.f;

  u32x4 rk[NK], rv[NV];
  const u16* kp[NK]; const u16* vp[NV];
  int ksto[NK], vsto[NV];
#pragma unroll
  for (int i = 0; i < NK; ++i) {
    int c = t + i * NTHR; if (c >= TK * KCH) c -= NTHR;
    int row = c / KCH, kc = c % KCH;
    kp[i] = K + (size_t)row * ldk + kc * 8;
    ksto[i] = row * KS + kc * 16;
  }
#pragma unroll
  for (int i = 0; i < NV; ++i) {
    int c = t + i * NTHR; if (c >= TK * VCH) c -= NTHR;
    int row = c / VCH, vc = c % VCH;
    vp[i] = V + (size_t)row * ldv + vc * 8;
    vsto[i] = KT + row * VS + vc * 16;
  }
#define A_LOAD(kt)                                                                                          \
  {                                                                                                         \
    _Pragma("unroll") for (int i = 0; i < NK; ++i) gload16(rk[i], kp[i] + (size_t)(kt) * TK * ldk); \
    _Pragma("unroll") for (int i = 0; i < NV; ++i) gload16(rv[i], vp[i] + (size_t)(kt) * TK * ldv); \
  }
#define A_STORE(stg)                                                                           \
  {                                                                                            \
    _Pragma("unroll") for (int i = 0; i < NK; ++i) *(u32x4*)(smem + (stg) * STG + ksto[i]) = rk[i]; \
    _Pragma("unroll") for (int i = 0; i < NV; ++i) *(u32x4*)(smem + (stg) * STG + vsto[i]) = rv[i]; \
  }
  const int nt = T / TK;
  const int kfr0 = prow(l32) * KS + h * 16;
  const int qq = (lane & 15) >> 2, pp = lane & 3, blk = (lane >> 4) & 1;
  const int vfr0 = KT + (8 * h + qq) * VS + blk * 32 + pp * 8;

#define A_TIE() { _Pragma("unroll") for (int i = 0; i < NK; ++i) TIE(rk[i]); _Pragma("unroll") for (int i = 0; i < NV; ++i) TIE(rv[i]); }
  __builtin_amdgcn_s_waitcnt(0x0F70);
  A_LOAD(0);
  VM_WAIT(0);
  A_TIE();
  A_STORE(0);
  __syncthreads();
  float lrun = 0.f;
  for (int kt = 0; kt < nt; ++kt) {
    const int stg = kt & 1;
    { const int ktn = (kt + 1 < nt) ? kt + 1 : kt; A_LOAD(ktn); }
    __builtin_amdgcn_sched_barrier(0);
    const char* sb = smem + stg * STG;
    f32x16 s[NKB];
#pragma unroll
    for (int kb2 = 0; kb2 < NKB; kb2 += 2) {
      bf16x8 kf[2][DK / 16];
#pragma unroll
      for (int kc = 0; kc < DK / 16; ++kc)
#pragma unroll
        for (int u = 0; u < 2; ++u) kf[u][kc] = *(const bf16x8*)(sb + kfr0 + (kb2 + u) * 32 * KS + kc * 32);
      s[kb2] = MFMA(kf[0][0], qf[0], negm);
      s[kb2 + 1] = MFMA(kf[1][0], qf[0], negm);
#pragma unroll
      for (int kc = 1; kc < DK / 16; ++kc) {
        s[kb2] = MFMA(kf[0][kc], qf[kc], s[kb2]);
        s[kb2 + 1] = MFMA(kf[1][kc], qf[kc], s[kb2 + 1]);
      }
    }
    float mx = max3f(s[0][0], s[0][1], s[0][2]);
#pragma unroll
    for (int r = 3; r < 15; r += 2) mx = max3f(mx, s[0][r], s[0][r + 1]);
    mx = fmaxf(mx, s[0][15]);
#pragma unroll
    for (int kb = 1; kb < NKB; ++kb) {
#pragma unroll
      for (int r = 0; r < 16; r += 2) mx = max3f(mx, s[kb][r], s[kb][r + 1]);
    }
    mx = xhalf_max(mx);
    if (kt == 0 || __builtin_amdgcn_ballot_w64(mx > 8.0f) != 0ull) {
      const float delta = (kt == 0) ? mx : fmaxf(mx, 0.f);
      const float alpha = (kt == 0) ? 1.f : __builtin_amdgcn_exp2f(-delta);
      mref += delta;
#pragma unroll
      for (int r = 0; r < 16; ++r) negm[r] = -mref;
      lrun *= alpha;
#pragma unroll
      for (int d = 0; d < DV / 32; ++d)
#pragma unroll
        for (int r = 0; r < 16; ++r) o[d][r] *= alpha;
#pragma unroll
      for (int kb = 0; kb < NKB; ++kb)
#pragma unroll
        for (int r = 0; r < 16; ++r) s[kb][r] -= delta;
    }
#define AT_EXPCVT(kb, PF)                                                                              \
    {                                                                                                  \
      _Pragma("unroll") for (int u = 0; u < 2; ++u) {                                                  \
        float e_[8];                                                                                   \
        _Pragma("unroll") for (int j = 0; j < 8; ++j) { e_[j] = __builtin_amdgcn_exp2f(s[kb][u * 8 + j]); lrun += e_[j]; } \
        uint4 pu_ = {pk2(e_[0], e_[1]), pk2(e_[2], e_[3]), pk2(e_[4], e_[5]), pk2(e_[6], e_[7])};      \
        PF[u] = __builtin_bit_cast(bf16x8, pu_);                                                       \
      }                                                                                                \
    }
#define AT_READV(kb, VF)                                                                               \
    {                                                                                                  \
      _Pragma("unroll") for (int u = 0; u < 2; ++u)                                                    \
        _Pragma("unroll") for (int d = 0; d < DV / 32; ++d) {                                          \
          const char* va = sb + vfr0 + ((kb) * 2 + u) * 16 * VS + d * 64;                              \
          s16x4 lo = __builtin_amdgcn_ds_read_tr16_b64_v4i16((lds_s16x4*)(va));                        \
          s16x4 hi = __builtin_amdgcn_ds_read_tr16_b64_v4i16((lds_s16x4*)(va + 4 * VS));              \
          VF[u][d] = __builtin_shufflevector(lo, hi, 0, 1, 2, 3, 4, 5, 6, 7);                          \
        }                                                                                              \
    }
#define AT_PVM(PF, VF)                                                                                 \
    {                                                                                                  \
      _Pragma("unroll") for (int u = 0; u < 2; ++u) {                                                  \
        _Pragma("unroll") for (int d = 0; d < DV / 32; ++d) o[d] = MFMA(VF[u][d], PF[u], o[d]);        \
      }                                                                                                \
    }
#define AT_SCHED_STAGE()     \
    {                                                                                                  \
      _Pragma("unroll") for (int i_ = 0; i_ < 2 * (DV / 32); ++i_) {                                     \
        __builtin_amdgcn_sched_group_barrier(0x008, 1, 0);                                             \
        __builtin_amdgcn_sched_group_barrier(0x002, (DV == 64) ? 10 : 5, 0);                           \
        __builtin_amdgcn_sched_group_barrier(0x100, 2, 0);                                             \
      }                                                                                                \
    }
    {
      bf16x8 pfA[2], pfB[2], vfA[2][DV / 32], vfB[2][DV / 32];
      AT_EXPCVT(0, pfA);
      AT_READV(0, vfA);
#pragma unroll
      for (int kb = 0; kb < NKB; kb += 2) {
        AT_EXPCVT(kb + 1, pfB);
        AT_READV(kb + 1, vfB);
        AT_PVM(pfA, vfA);
        if (kb + 2 < NKB) {
          AT_EXPCVT(kb + 2, pfA);
          AT_READV(kb + 2, vfA);
        }
        AT_PVM(pfB, vfB);
      }
      __builtin_amdgcn_sched_group_barrier(0x002, 44, 0);
      __builtin_amdgcn_sched_group_barrier(0x100, 4 * (DV / 32), 0);
#pragma unroll
      for (int st_ = 0; st_ < NKB - 1; ++st_) AT_SCHED_STAGE();
      __builtin_amdgcn_sched_group_barrier(0x008, 2 * (DV / 32), 0);
    }
#undef AT_EXPCVT
#undef AT_READV
#undef AT_PVM
#undef AT_SCHED_STAGE
    VM_WAIT(0);
    A_TIE();
    A_STORE(stg ^ 1);
    __syncthreads();
  }
#undef A_TIE
#undef A_LOAD
#undef A_STORE
  const float inv = 1.f / (lrun + xhalf(lrun, h));
  u16* orow = O + (size_t)(w * 32 + l32) * ldo;
#pragma unroll
  for (int d = 0; d < DV / 32; ++d)
#pragma unroll
    for (int q = 0; q < 4; q += 2) {
      uint2 oa = {pk2(o[d][q * 4] * inv, o[d][q * 4 + 1] * inv), pk2(o[d][q * 4 + 2] * inv, o[d][q * 4 + 3] * inv)};
      uint2 ob = {pk2(o[d][q * 4 + 4] * inv, o[d][q * 4 + 5] * inv), pk2(o[d][q * 4 + 6] * inv, o[d][q * 4 + 7] * inv)};
      store_pair16(orow + d * 32 + q * 8, oa, ob, h);
    }
}

template <int DK>
DI void attn_block_dma(const u16* __restrict__ Q, int ldq, const u16* __restrict__ K, int ldk, const u16* __restrict__ V, int ldv,
                   u16* __restrict__ O, int ldo, int T, char* smem) {
  constexpr int DV = 64, TK = 128, NKB = 4;
  constexpr int KBY = DK * 2, KG = DK / 8;
  constexpr int KT = TK * KBY, STG = KT + TK * 128;
  constexpr int NKP = KT / 1024, NPW = (NKP + 16) / 8;
  static_assert(2 * STG <= 2 * G_STAGE, "LDS");
  const int t = tid_opaque(), lane = t & 63, w = t >> 6, l32 = lane & 31, h = lane >> 5;


  f32x16 o[DV / 32];
#pragma unroll
  for (int d = 0; d < DV / 32; ++d)
#pragma unroll
    for (int r = 0; r < 16; ++r) o[d][r] = 0.f;
  float mref = 0.f;
  f32x16 negm;
#pragma unroll
  for (int r = 0; r < 16; ++r) negm[r] = 0.f;

  const u16* psrc[NPW]; unsigned pdst[NPW];
  const unsigned lds0 = (unsigned)(size_t)smem;
#pragma unroll
  for (int i = 0; i < NPW; ++i) {
    const int pz = w + 8 * i;
    if (i * 8 < NKP) {
      const int S = pz * 64 + lane, r = S / KG, slot = S % KG;
      const int gg = (DK == 64) ? (slot ^ ((r >> 1) & 7)) : ((slot + 12 - ((r >> 2) & 3)) % 12);
      psrc[i] = K + (size_t)r * ldk + gg * 8;
      pdst[i] = pz * 1024;
    } else {
      const int S = (pz - NKP) * 64 + lane, r = S >> 3, slot = S & 7;
      const int gg = slot ^ (((r >> 1) & 1) << 2);
      psrc[i] = V + (size_t)r * ldv + gg * 8;
      pdst[i] = KT + (pz - NKP) * 1024;
    }
  }
#define A_DMA(kt, stg)                                                                        \
  {                                                                                           \
    _Pragma("unroll") for (int i = 0; i < NPW; ++i)                                           \
      glds16(psrc[i] + (size_t)(kt) * TK * ((i * 8 < NKP) ? ldk : ldv),                       \
             __builtin_amdgcn_readfirstlane(lds0 + (stg) * STG + pdst[i]));                   \
  }
  const int nt = T / TK;
  const int krow = prow(l32);
  int kslot[DK / 16];
#pragma unroll
  for (int kc = 0; kc < DK / 16; ++kc) {
    if (DK == 64) kslot[kc] = ((kc * 2 + h) ^ ((krow >> 1) & 7)) * 16;
    else { const int tt = kc * 2 + h + ((krow >> 2) & 3); kslot[kc] = (tt >= 12 ? tt - 12 : tt) * 16; }
  }
  const int kfr0 = krow * KBY;
  const int qq = (lane & 15) >> 2, pp = lane & 3, blk = (lane >> 4) & 1;
  const int vxb = (qq >> 1) & 1;
  const int vfr0 = KT + (8 * h + qq) * 128 + (blk * 2 + (pp >> 1)) * 16 + (pp & 1) * 8;
  const int vd0 = vxb * 64, vd1 = (1 - vxb) * 64;

  __builtin_amdgcn_s_waitcnt(0x0F70);
  A_DMA(0, 0);
  bf16x8 qf[DK / 16];
#pragma unroll
  for (int kc = 0; kc < DK / 16; ++kc) qf[kc] = *(const bf16x8*)(Q + (size_t)(w * 32 + l32) * ldq + kc * 16 + h * 8);
#pragma unroll
  for (int kc = 0; kc < DK / 16; ++kc) asm volatile("" ::"v"(qf[kc]));
  VM_WAIT(0);
  __syncthreads();
  float lrun = 0.f;
  for (int kt = 0; kt < nt; ++kt) {
    const int stg = kt & 1;
    if (kt + 1 < nt) A_DMA(kt + 1, stg ^ 1);
    __builtin_amdgcn_sched_barrier(0);
    const char* sb = smem + stg * STG;
    f32x16 s[NKB];
#pragma unroll
    for (int kb2 = 0; kb2 < NKB; kb2 += 2) {
      bf16x8 kf[2][DK / 16];
#pragma unroll
      for (int kc = 0; kc < DK / 16; ++kc)
#pragma unroll
        for (int u = 0; u < 2; ++u) kf[u][kc] = *(const bf16x8*)(sb + kfr0 + (kb2 + u) * 32 * KBY + kslot[kc]);
      s[kb2] = MFMA(kf[0][0], qf[0], negm);
      s[kb2 + 1] = MFMA(kf[1][0], qf[0], negm);
#pragma unroll
      for (int kc = 1; kc < DK / 16; ++kc) {
        s[kb2] = MFMA(kf[0][kc], qf[kc], s[kb2]);
        s[kb2 + 1] = MFMA(kf[1][kc], qf[kc], s[kb2 + 1]);
      }
    }
    float mx = max3f(s[0][0], s[0][1], s[0][2]);
#pragma unroll
    for (int r = 3; r < 15; r += 2) mx = max3f(mx, s[0][r], s[0][r + 1]);
    mx = fmaxf(mx, s[0][15]);
#pragma unroll
    for (int kb = 1; kb < NKB; ++kb) {
#pragma unroll
      for (int r = 0; r < 16; r += 2) mx = max3f(mx, s[kb][r], s[kb][r + 1]);
    }
    mx = xhalf_max(mx);
    if (kt == 0 || __builtin_amdgcn_ballot_w64(mx > 8.0f) != 0ull) {
      const float delta = (kt == 0) ? mx : fmaxf(mx, 0.f);
      const float alpha = (kt == 0) ? 1.f : __builtin_amdgcn_exp2f(-delta);
      mref += delta;
#pragma unroll
      for (int r = 0; r < 16; ++r) negm[r] = -mref;
      lrun *= alpha;
#pragma unroll
      for (int d = 0; d < DV / 32; ++d)
#pragma unroll
        for (int r = 0; r < 16; ++r) o[d][r] *= alpha;
#pragma unroll
      for (int kb = 0; kb < NKB; ++kb)
#pragma unroll
        for (int r = 0; r < 16; ++r) s[kb][r] -= delta;
    }
#define AT_EXPCVT(kb, PF)                                                                              \
    {                                                                                                  \
      _Pragma("unroll") for (int u = 0; u < 2; ++u) {                                                  \
        float e_[8];                                                                                   \
        _Pragma("unroll") for (int j = 0; j < 8; ++j) { e_[j] = __builtin_amdgcn_exp2f(s[kb][u * 8 + j]); lrun += e_[j]; } \
        uint4 pu_ = {pk2(e_[0], e_[1]), pk2(e_[2], e_[3]), pk2(e_[4], e_[5]), pk2(e_[6], e_[7])};      \
        PF[u] = __builtin_bit_cast(bf16x8, pu_);                                                       \
      }                                                                                                \
    }
#define AT_READV(kb, VF)                                                                               \
    {                                                                                                  \
      _Pragma("unroll") for (int u = 0; u < 2; ++u)                                                    \
        _Pragma("unroll") for (int d = 0; d < DV / 32; ++d) {                                          \
          const char* va = sb + vfr0 + ((kb) * 2 + u) * 16 * 128 + (d ? vd1 : vd0);                    \
          s16x4 lo = __builtin_amdgcn_ds_read_tr16_b64_v4i16((lds_s16x4*)(va));                        \
          s16x4 hi = __builtin_amdgcn_ds_read_tr16_b64_v4i16((lds_s16x4*)(va + 4 * 128));             \
          VF[u][d] = __builtin_shufflevector(lo, hi, 0, 1, 2, 3, 4, 5, 6, 7);                          \
        }                                                                                              \
    }
#define AT_PVM(PF, VF)                                                                                 \
    {                                                                                                  \
      _Pragma("unroll") for (int u = 0; u < 2; ++u) {                                                  \
        _Pragma("unroll") for (int d = 0; d < DV / 32; ++d) o[d] = MFMA(VF[u][d], PF[u], o[d]);        \
      }                                                                                                \
    }
#define AT_SCHED_STAGE()     \
    {                                                                                                  \
      _Pragma("unroll") for (int i_ = 0; i_ < 2 * (DV / 32); ++i_) {                                     \
        __builtin_amdgcn_sched_group_barrier(0x008, 1, 0);                                             \
        __builtin_amdgcn_sched_group_barrier(0x002, (DV == 64) ? 10 : 5, 0);                           \
        __builtin_amdgcn_sched_group_barrier(0x100, 2, 0);                                             \
      }                                                                                                \
    }
    {
      bf16x8 pfA[2], pfB[2], vfA[2][DV / 32], vfB[2][DV / 32];
      AT_EXPCVT(0, pfA);
      AT_READV(0, vfA);
#pragma unroll
      for (int kb = 0; kb < NKB; kb += 2) {
        AT_EXPCVT(kb + 1, pfB);
        AT_READV(kb + 1, vfB);
        AT_PVM(pfA, vfA);
        if (kb + 2 < NKB) {
          AT_EXPCVT(kb + 2, pfA);
          AT_READV(kb + 2, vfA);
        }
        AT_PVM(pfB, vfB);
      }
      __builtin_amdgcn_sched_group_barrier(0x002, 44, 0);
      __builtin_amdgcn_sched_group_barrier(0x100, 4 * (DV / 32), 0);
#pragma unroll
      for (int st_ = 0; st_ < NKB - 1; ++st_) AT_SCHED_STAGE();
      __builtin_amdgcn_sched_group_barrier(0x008, 2 * (DV / 32), 0);
    }
#undef AT_EXPCVT
#undef AT_READV
#undef AT_PVM
#undef AT_SCHED_STAGE
    VM_WAIT(0);
    __syncthreads();
  }
#undef A_DMA
  const float inv = 1.f / (lrun + xhalf(lrun, h));
  u16* orow = O + (size_t)(w * 32 + l32) * ldo;
#pragma unroll
  for (int d = 0; d < DV / 32; ++d)
#pragma unroll
    for (int q = 0; q < 4; q += 2) {
      uint2 oa = {pk2(o[d][q * 4] * inv, o[d][q * 4 + 1] * inv), pk2(o[d][q * 4 + 2] * inv, o[d][q * 4 + 3] * inv)};
      uint2 ob = {pk2(o[d][q * 4 + 4] * inv, o[d][q * 4 + 5] * inv), pk2(o[d][q * 4 + 6] * inv, o[d][q * 4 + 7] * inv)};
      store_pair16(orow + d * 32 + q * 8, oa, ob, h);
    }
}

DI void gmlp_phase(const u16* __restrict__ z, const u16* __restrict__ ws_bf, const float* __restrict__ bs, u16* __restrict__ y, char* smem) {
  constexpr int VS = 64 * 2 + 64;
  const int t = tid_opaque(), lane = t & 63, w = t >> 6, l32 = lane & 31, h = lane >> 5;
  const int qq = (lane & 15) >> 2, pp = lane & 3, blk = (lane >> 4) & 1;
  for (int job = blockIdx.x; job < 512 * 2; job += gridDim.x) {
    const int chunk = job >> 1, grp = (job & 1) * 2 + (w >> 2);
    const size_t tok0 = (size_t)chunk * 128;
    char* const sm = smem + (w >> 2) * (128 * VS);
#pragma unroll
    for (int i = 0; i < 4; ++i) {
      int c = t + i * NTHR, gl = c >> 10, row = (c >> 3) & 127, vc = c & 7;
      uint4 v = *(const uint4*)(z + (tok0 + row) * DIN + 1312 + ((job & 1) * 2 + gl) * 64 + vc * 8);
      *(uint4*)(smem + gl * (128 * VS) + row * VS + vc * 16) = v;
    }
    __syncthreads();
    f32x16 acc[2];
#pragma unroll
    for (int d = 0; d < 2; ++d)
#pragma unroll
      for (int r = 0; r < 16; ++r) acc[d][r] = 0.f;
    const int p = (w & 3) * 32 + l32;
#pragma unroll
    for (int ks = 0; ks < 8; ++ks) {
      bf16x8 wf = *(const bf16x8*)(ws_bf + (size_t)grp * 16384 + p * 128 + ks * 16 + h * 8);
#pragma unroll
      for (int d = 0; d < 2; ++d) {
        const char* va = sm + (ks * 16 + 8 * h + qq) * VS + d * 64 + blk * 32 + pp * 8;
        s16x4 lo = __builtin_amdgcn_ds_read_tr16_b64_v4i16((lds_s16x4*)(va));
        s16x4 hi = __builtin_amdgcn_ds_read_tr16_b64_v4i16((lds_s16x4*)(va + 4 * VS));
        bf16x8 vf = __builtin_shufflevector(lo, hi, 0, 1, 2, 3, 4, 5, 6, 7);
        acc[d] = MFMA(vf, wf, acc[d]);
      }
    }
    const float bias = bs[grp * 128 + p];
    const u16* ur = z + (tok0 + p) * DIN + 1056 + grp * 64;
    u16* yr = y + (tok0 + p) * DM + 768 + grp * 64;
#pragma unroll
    for (int d = 0; d < 2; ++d)
#pragma unroll
      for (int q = 0; q < 4; q += 2) {
        uint2 ov[2];
#pragma unroll
        for (int k = 0; k < 2; ++k) {
          const int c = d * 32 + (q + k) * 8 + h * 4;
          uint2 u = *(const uint2*)(ur + c);
          ov[k].x = pk2(bflo(u.x) * (acc[d][(q + k) * 4] + bias), bfhi(u.x) * (acc[d][(q + k) * 4 + 1] + bias));
          ov[k].y = pk2(bflo(u.y) * (acc[d][(q + k) * 4 + 2] + bias), bfhi(u.y) * (acc[d][(q + k) * 4 + 3] + bias));
        }
        store_pair16(yr + d * 32 + q * 8, ov[0], ov[1], h);
      }
    __syncthreads();
  }
}

DI void grid_barrier(unsigned* ctr, unsigned& target) {
  __syncthreads();
  target += 1;
  if (threadIdx.x == 0) {
    __builtin_amdgcn_fence(__ATOMIC_RELEASE, "agent");
    unsigned* top = ctr;
    if ((gridDim.x & 7) == 0) {
      const unsigned gsz = gridDim.x >> 3;
      unsigned* gc = ctr + 32 * (1 + (blockIdx.x & 7));
      const unsigned old = __hip_atomic_fetch_add(gc, 1u, __ATOMIC_RELAXED, __HIP_MEMORY_SCOPE_AGENT);
      if (old + 1 == target * gsz) __hip_atomic_fetch_add(top, 1u, __ATOMIC_RELAXED, __HIP_MEMORY_SCOPE_AGENT);
      while (__hip_atomic_load(top, __ATOMIC_RELAXED, __HIP_MEMORY_SCOPE_AGENT) < target * 8u) __builtin_amdgcn_s_sleep(1);
    } else {
      __hip_atomic_fetch_add(top, 1u, __ATOMIC_RELAXED, __HIP_MEMORY_SCOPE_AGENT);
      while (__hip_atomic_load(top, __ATOMIC_RELAXED, __HIP_MEMORY_SCOPE_AGENT) < target * gridDim.x) __builtin_amdgcn_s_sleep(1);
    }
    __builtin_amdgcn_fence(__ATOMIC_ACQUIRE, "agent");
  }
  __syncthreads();
}

constexpr int SMEM_BYTES = 2 * G_STAGE;

__global__ void __launch_bounds__(512) fwd_megakernel(Params p) {
  cg::grid_group grid = cg::this_grid();
  __shared__ __attribute__((aligned(16))) char smem[SMEM_BYTES];
  char* ws = p.ws;
  u16* Wb = (u16*)(ws + OFF_W);
  float* cosA = (float*)(ws + OFF_ROPE);
  float* sinA = cosA + SEQ * 16;
  float* cosB = sinA + SEQ * 16;
  float* sinB = cosB + SEQ * 32;
  u16* memn = (u16*)(ws + OFF_MEMN);
  u16* memkv = (u16*)(ws + OFF_MEMKV);
  u16* H = (u16*)(ws + OFF_H);
  u16* Z = (u16*)(ws + OFF_Z);
  u16* Y = (u16*)(ws + OFF_Y);
  u16* QM = Y;
  u16* OM = (u16*)(ws + OFF_Y + 64 * MiB);
  u16* QA = (u16*)(ws + OFF_QA);
  u16* KA = (u16*)(ws + OFF_KA);
  u16* VA = (u16*)(ws + OFF_VA);
  float* X = p.out;
  unsigned* bar = (unsigned*)(ws + OFF_BAR);
  unsigned bar_target = 0;

  for (int l = 0; l < 2; ++l) {
    u16* wl = Wb + l * W_LAYER;
    transpose_phase(p.in[3] + (size_t)l * 1024 * 1568, 1024, 1568, wl + W_IN, false, smem);
    transpose_phase(p.in[5] + (size_t)l * 256 * 576, 256, 576, wl + W_UQ, false, smem);
    transpose_phase(p.in[7] + (size_t)l * 128 * 768, 128, 768, wl + W_UKV, false, smem);
    transpose_phase(p.in[14] + (size_t)l * 1024 * 1024, 1024, 1024, wl + W_OUT, false, smem);
    transpose_phase(p.in[17] + (size_t)l * 1024 * 512, 1024, 512, wl + W_MQ, false, smem);
    transpose_phase(p.in[18] + (size_t)l * 1024 * 1024, 1024, 1024, wl + W_MKV, false, smem);
    transpose_phase(p.in[19] + (size_t)l * 512 * 1024, 512, 1024, wl + W_MO, false, smem);
    transpose_phase(p.in[21] + (size_t)l * 1024 * 5632, 1024, 5632, wl + W_UP, true, smem);
    transpose_phase(p.in[24] + (size_t)l * 2816 * 1024, 2816, 1024, wl + W_DN, false, smem);
    const float* wsrc = p.in[11] + (size_t)l * 65536;
    for (int i = blockIdx.x * NTHR + tid_opaque(); i < 32768; i += gridDim.x * NTHR)
      *(unsigned*)(wl + W_S + i * 2) = pk2(wsrc[i * 2], wsrc[i * 2 + 1]);
    norm_rows_bf16(p.in[1], p.in[16] + l * DM, memn + (size_t)l * NMEM * DM, NMEM);
  }
  for (int i = blockIdx.x * NTHR + tid_opaque(); i < SEQ * 16; i += gridDim.x * NTHR) {
    int s = i >> 4, pi = i & 15;
    float pos = (pi < 8) ? (float)(s >> 6) : (float)(s & 63);
    float inv = powf(10000.f, -(float)(pi & 7) / 8.f);
    float ang = pos * inv;
    cosA[i] = cosf(ang); sinA[i] = sinf(ang);
  }
  for (int i = blockIdx.x * NTHR + tid_opaque(); i < SEQ * 32; i += gridDim.x * NTHR) {
    int s = i >> 5, pi = i & 31;
    float pos = (pi < 16) ? (float)(s >> 6) : (float)(s & 63);
    float inv = powf(10000.f, -(float)(pi & 15) / 16.f);
    float ang = pos * inv;
    cosB[i] = cosf(ang); sinB[i] = sinf(ang);
  }
  norm_rows_bf16(p.in[0], p.in[2], H, NTOK);
  grid.sync();

  for (int l = 0; l < 2; ++l) {
    GemmArgs g{};
    g.A = memn + (size_t)l * NMEM * DM; g.lda = DM; g.W = Wb + l * W_LAYER + W_MKV; g.ldw = DM;
    g.M = NMEM; g.N = 1024; g.K = 1024; g.epi = EPI_BF16; g.out = memkv + (size_t)l * NMEM * DM; g.ldo = DM; g.scale = 1.f;
    gemm_phase<false>(g, smem);
  }

  for (int l = 0; l < 2; ++l) {
    const u16* wl = Wb + l * W_LAYER;
    const float* xsrc = (l == 0) ? p.in[0] : X;
    {
      GemmArgs g{};
      g.A = H; g.lda = DM; g.W = wl + W_IN; g.ldw = DM; g.M = NTOK; g.N = DIN; g.K = DM; g.epi = EPI_BF16;
      g.out = Z; g.ldo = DIN; g.scale = 1.f;
      gemm_phase<false>(g, smem);
    }
    grid_barrier(bar, bar_target);
    {
      PostArgs a;
      a.z = Z; a.ka = KA;
      a.qn = p.in[4] + l * 256; a.kvn = p.in[6] + l * 128; a.gq = p.in[8] + l * 64; a.gk = p.in[9] + l * 64; a.gv = p.in[10] + l * 256;
      a.cosA = cosA; a.sinA = sinA; a.cosB = cosB; a.sinB = sinB;
      post_phase(a);
    }
    grid_barrier(bar, bar_target);
    {
      GemmArgs g{};
      g.A = Z; g.lda = DIN; g.W = wl + W_UQ; g.ldw = 256; g.M = NTOK; g.N = 576; g.K = 256; g.epi = EPI_QA;
      g.out = QA; g.ldo = 576; g.scale = 0.10206207261596575f * LOG2E; g.cosA = cosA; g.sinA = sinA;
      gemm_phase<false>(g, smem);
      GemmArgs g2{};
      g2.A = Z + 256; g2.lda = DIN; g2.W = wl + W_UKV; g2.ldw = 128; g2.M = NTOK; g2.N = 768; g2.K = 128; g2.epi = EPI_KVA;
      g2.out = KA; g2.out2 = VA;
      gemm_phase<false>(g2, smem);
      gmlp_phase(Z, wl + W_S, p.in[12] + l * 512, Y, smem);
    }
    grid_barrier(bar, bar_target);
    for (int jb = blockIdx.x; jb < 256; jb += gridDim.x) {
      const int b = jb & 7, qt = jb >> 3;
      const size_t tq = (size_t)b * SEQ + qt * 256, tk = (size_t)b * SEQ;
#pragma unroll 1
      for (int hd = 0; hd < 6; ++hd)
        attn_block_dma<96>(QA + tq * 576 + hd * 96, 576, KA + tk * 576 + hd * 96, 576, VA + tk * 384 + hd * 64, 384,
                           Y + tq * DM + hd * 64, DM, SEQ, smem);
#pragma unroll 1
      for (int hd = 0; hd < 6; ++hd) {
        const int kvh = hd / 3;
        attn_block_dma<64>(Z + tq * DIN + 416 + hd * 64, DIN, Z + tk * DIN + 800 + kvh * 64, DIN, Z + tk * DIN + 928 + kvh * 64, DIN,
                           Y + tq * DM + 384 + hd * 64, DM, SEQ, smem);
      }
      __builtin_amdgcn_fence(__ATOMIC_RELEASE, "workgroup");
      __syncthreads();
      __builtin_amdgcn_fence(__ATOMIC_ACQUIRE, "agent");
      outnorm_rows(Y, p.in[13] + l * DM, H, (int)tq);
    }
    grid_barrier(bar, bar_target);
    {
      GemmArgs g{};
      g.A = H; g.lda = DM; g.W = wl + W_OUT; g.ldw = DM; g.M = NTOK; g.N = DM; g.K = DM; g.epi = EPI_RESID;
      g.res = xsrc; g.outf = X;
      gemm_phase<false>(g, smem);
    }
    grid_barrier(bar, bar_target);
    norm_rows_bf16(X, p.in[15] + l * DM, H, NTOK);
    grid_barrier(bar, bar_target);
    {
      GemmArgs g{};
      g.A = H; g.lda = DM; g.W = wl + W_MQ; g.ldw = DM; g.M = NTOK; g.N = 512; g.K = DM; g.epi = EPI_BF16;
      g.out = QM; g.ldo = 512; g.scale = 0.08838834764831845f * LOG2E;
      gemm_phase<false>(g, smem);
    }
    grid_barrier(bar, bar_target);
    for (int j = blockIdx.x; j < 1024; j += gridDim.x) {
      const int x = j & 7, jj = j >> 3;
      const int pair = x + 8 * (jj >> 5), qt = jj & 31;
      const int b = pair >> 2, hd = pair & 3;
      const size_t tq = (size_t)b * SEQ + qt * 256;
      const u16* kv = memkv + (size_t)l * NMEM * DM + (size_t)b * 256 * DM;
      attn_block<128, 128>(QM + tq * 512 + hd * 128, 512, kv + hd * 128, DM, kv + 512 + hd * 128, DM, OM + tq * 512 + hd * 128, 512, 256, smem);
    }
    grid_barrier(bar, bar_target);
    {
      GemmArgs g{};
      g.A = OM; g.lda = 512; g.W = wl + W_MO; g.ldw = 512; g.M = NTOK; g.N = DM; g.K = 512; g.epi = EPI_RESID;
      g.res = X; g.outf = X;
      gemm_phase<false>(g, smem);
    }
    grid_barrier(bar, bar_target);
    norm_rows_bf16(X, p.in[20] + l * DM, H, NTOK);
    grid_barrier(bar, bar_target);
    {
      GemmArgs g{};
      g.A = H; g.lda = DM; g.W = wl + W_UP; g.ldw = DM; g.M = NTOK; g.N = 2 * DFF; g.K = DM; g.epi = 0;
      g.out = Z; g.convw = p.in[22] + (size_t)l * 3 * 2 * DFF; g.convb = p.in[23] + (size_t)l * 2 * DFF;
      gemm_phase<true>(g, smem);
    }
    grid_barrier(bar, bar_target);
    {
      GemmArgs g{};
      g.A = Z; g.lda = DFF; g.W = wl + W_DN; g.ldw = DFF; g.M = NTOK; g.N = DM; g.K = DFF; g.epi = EPI_RESID;
      g.res = X; g.outf = X;
      gemm_phase<false>(g, smem);
    }
    grid_barrier(bar, bar_target);
    if (l == 0) {
      norm_rows_bf16(X, p.in[2] + DM, H, NTOK);
    } else {
      final_norm_rows(X, p.in[25], NTOK);
    }
    if (l == 0) grid_barrier(bar, bar_target);
  }
}

extern "C" void kernel_launch(void* const* d_in, const int* in_sizes, int n_in, void* d_out, int out_size, void* d_ws, size_t ws_size,
                              hipStream_t stream) {
  static int grid_blocks = 0;
  if (!grid_blocks) {
    int dev = 0, cus = 0, per_cu = 0;
    hipGetDevice(&dev);
    hipDeviceGetAttribute(&cus, hipDeviceAttributeMultiprocessorCount, dev);
    hipOccupancyMaxActiveBlocksPerMultiprocessor(&per_cu, fwd_megakernel, NTHR, 0);
    if (per_cu > 1) per_cu = 1;
    if (per_cu < 1) per_cu = 1;
    grid_blocks = cus * per_cu;
  }
  Params p{};
  for (int i = 0; i < 26; ++i) p.in[i] = (const float*)d_in[i];
  p.out = (float*)d_out;
  p.ws = (char*)d_ws;
  hipMemsetAsync((char*)d_ws + OFF_BAR, 0, 2048, stream);
  void* args[] = {&p};
  hipError_t e = hipLaunchCooperativeKernel((void*)fwd_megakernel, dim3(grid_blocks), dim3(NTHR), args, 0, stream);
  if (e != hipSuccess) fprintf(stderr, "cooperative launch failed: %s (grid %d)\n", hipGetErrorString(e), grid_blocks);
}
```

```cpp
#include <hip/hip_runtime.h>
#include <hip/hip_cooperative_groups.h>
#include <cstdio>
namespace cg = cooperative_groups;

typedef unsigned short u16;
typedef __attribute__((ext_vector_type(8))) short bf16x8;
typedef __attribute__((ext_vector_type(4))) short s16x4;
typedef __attribute__((ext_vector_type(16))) float f32x16;
typedef __attribute__((ext_vector_type(2))) __bf16 bf2_t;
typedef __attribute__((ext_vector_type(2))) float f2_t;
typedef __attribute__((address_space(3))) s16x4 lds_s16x4;
typedef __attribute__((ext_vector_type(4))) unsigned u32x4;

#define DI __device__ __forceinline__
#define MFMA(a, b, c) __builtin_amdgcn_mfma_f32_32x32x16_bf16((a), (b), (c), 0, 0, 0)

constexpr int NTOK = 65536, SEQ = 8192, NB = 8, DM = 1024, DIN = 1568, DFF = 2816, NMEM = 2048;
constexpr float LOG2E = 1.4426950408889634f;
constexpr float EPSF = 1e-6f;
constexpr int NTHR = 512, NWAVE = 8;

constexpr size_t MiB = 1ull << 20;
constexpr size_t W_IN = 0, W_UQ = W_IN + 1568ull * 1024, W_UKV = W_UQ + 576ull * 256, W_OUT = W_UKV + 768ull * 128,
                 W_MQ = W_OUT + 1024ull * 1024, W_MKV = W_MQ + 512ull * 1024, W_MO = W_MKV + 1024ull * 1024,
                 W_UP = W_MO + 1024ull * 512, W_DN = W_UP + 5632ull * 1024, W_S = W_DN + 1024ull * 2816,
                 W_LAYER = W_S + 4ull * 128 * 128;
constexpr size_t OFF_W = 0;
constexpr size_t OFF_ROPE = 56 * MiB;
constexpr size_t OFF_MEMN = 60 * MiB;
constexpr size_t OFF_MEMKV = 68 * MiB;
constexpr size_t OFF_H = 76 * MiB;
constexpr size_t OFF_Z = 204 * MiB;
constexpr size_t OFF_Y = 556 * MiB;
constexpr size_t OFF_QA = 684 * MiB;
constexpr size_t OFF_KA = 756 * MiB;
constexpr size_t OFF_VA = 828 * MiB;
constexpr size_t OFF_BAR = 940 * MiB;

struct Params {
  const float* in[26];
  float* out;
  char* ws;
};

DI int tid_opaque() { int t = threadIdx.x; asm volatile("" : "+v"(t)); return t; }
DI void gload16(u32x4& r, const void* p) { asm volatile("global_load_dwordx4 %0, %1, off" : "=v"(r) : "v"(p) : "memory"); }
DI void glds16(const void* gsrc, unsigned lds_dst) {
  unsigned keep;
  asm volatile("s_mov_b32 %0, m0\n\ts_mov_b32 m0, %2\n\ts_nop 0\n\tglobal_load_lds_dwordx4 %1, off\n\ts_mov_b32 m0, %0" : "=&s"(keep) : "v"(gsrc), "s"(lds_dst) : "memory");
}
#define VM_WAIT(n) asm volatile("s_waitcnt vmcnt(" #n ")" ::: "memory")
#define TIE(x) asm volatile("" : "+v"(x))
DI unsigned pk2(float a, float b) { f2_t v = {a, b}; bf2_t r = __builtin_convertvector(v, bf2_t); return __builtin_bit_cast(unsigned, r); }
DI float bflo(unsigned u) { return __uint_as_float(u << 16); }
DI float bfhi(unsigned u) { return __uint_as_float(u & 0xffff0000u); }
DI float wave_sum(float v) {
#pragma unroll
  for (int o = 32; o; o >>= 1) v += __shfl_xor(v, o);
  return v;
}
DI float half_sum(float v) {
#pragma unroll
  for (int o = 16; o; o >>= 1) v += __shfl_xor(v, o);
  return v;
}
DI float xhalf(float v, int h) {
  auto r = __builtin_amdgcn_permlane32_swap(__float_as_uint(v), __float_as_uint(v), false, false);
  return __uint_as_float(h ? r[0] : r[1]);
}
DI float dpp_xor1(float v) {
  return __uint_as_float(__builtin_amdgcn_update_dpp(0u, __float_as_uint(v), 0xB1, 0xf, 0xf, true));
}
DI void store_pair16(u16* p8k, uint2 a, uint2 b, int h) {
  auto r0 = __builtin_amdgcn_permlane32_swap(a.x, b.x, false, false);
  auto r1 = __builtin_amdgcn_permlane32_swap(a.y, b.y, false, false);
  uint4 v = {r0[0], r1[0], r0[1], r1[1]};
  *(uint4*)(p8k + (h ? 8 : 0)) = v;
}
DI float gelu_tanh(float x) {
  float y = 0.7978845608028654f * (x + 0.044715f * x * x * x);
  float e = __expf(2.f * y);
  float th = 1.f - 2.f / (1.f + e);
  return 0.5f * x * (1.f + th);
}

DI void transpose_phase(const float* __restrict__ in, int K, int N, u16* __restrict__ out, bool ffn_perm, char* smem) {
  const int tt = tid_opaque();
  const int half = tt >> 8, t = tt & 255;
  float(*tile)[33] = (float(*)[33])(smem + half * (64 * 33 * 4));
  const int nkt = K / 64, nnt = N / 32, njobs = nkt * nnt;
  for (int jp = blockIdx.x; jp * 2 < njobs; jp += gridDim.x) {
    const int job = jp * 2 + half;
    const bool ok = job < njobs;
    const int kt = job % nkt, ntile = job / nkt;
    const int kbase = kt * 64, nbase = ntile * 32;
    const int src = ffn_perm ? ((ntile & 1) * DFF + (ntile >> 1) * 32) : nbase;
    if (ok) {
#pragma unroll
      for (int it = 0; it < 2; ++it) {
        const int k = it * 32 + (t >> 3), n4 = (t & 7) * 4;
        const float4 v = *(const float4*)(in + (size_t)(kbase + k) * N + src + n4);
        tile[k][n4] = v.x; tile[k][n4 + 1] = v.y; tile[k][n4 + 2] = v.z; tile[k][n4 + 3] = v.w;
      }
    }
    __syncthreads();
    if (ok) {
      int n = t >> 3, kq = t & 7;
      float v[8];
#pragma unroll
      for (int j = 0; j < 8; ++j) v[j] = tile[kq * 8 + j][n];
      uint4 r = {pk2(v[0], v[1]), pk2(v[2], v[3]), pk2(v[4], v[5]), pk2(v[6], v[7])};
      *(uint4*)(out + (size_t)(nbase + n) * K + kbase + kq * 8) = r;
    }
    __syncthreads();
  }
}

DI void norm_rows_bf16(const float* __restrict__ x, const float* __restrict__ gain, u16* __restrict__ out, int rows) {
  const int t = tid_opaque();
  const int lane = t & 63;
  const int wid = blockIdx.x * NWAVE + (t >> 6), nw = gridDim.x * NWAVE;
  float4 g[4];
#pragma unroll
  for (int j = 0; j < 4; ++j) g[j] = *(const float4*)(gain + j * 256 + lane * 4);
  for (int r = wid; r < rows; r += nw) {
    const float* xr = x + (size_t)r * DM;
    float4 v[4];
    float ss = 0.f;
#pragma unroll
    for (int j = 0; j < 4; ++j) {
      { typedef float f4_t __attribute__((ext_vector_type(4))); f4_t t4 = __builtin_nontemporal_load((const f4_t*)(xr + j * 256 + lane * 4)); v[j].x = t4.x; v[j].y = t4.y; v[j].z = t4.z; v[j].w = t4.w; }
      ss += v[j].x * v[j].x + v[j].y * v[j].y + v[j].z * v[j].z + v[j].w * v[j].w;
    }
    ss = wave_sum(ss);
    const float rs = rsqrtf(ss * (1.f / DM) + EPSF);
#pragma unroll
    for (int j = 0; j < 4; ++j) {
      uint2 o = {pk2(v[j].x * rs * g[j].x, v[j].y * rs * g[j].y), pk2(v[j].z * rs * g[j].z, v[j].w * rs * g[j].w)};
      *(uint2*)(out + (size_t)r * DM + j * 256 + lane * 4) = o;
    }
  }
}

DI void final_norm_rows(float* __restrict__ x, const float* __restrict__ gain, int rows) {
  const int t = tid_opaque();
  const int lane = t & 63;
  const int wid = blockIdx.x * NWAVE + (t >> 6), nw = gridDim.x * NWAVE;
  float4 g[4];
#pragma unroll
  for (int j = 0; j < 4; ++j) g[j] = *(const float4*)(gain + j * 256 + lane * 4);
  for (int r = wid; r < rows; r += nw) {
    float* xr = x + (size_t)r * DM;
    float4 v[4];
    float ss = 0.f;
#pragma unroll
    for (int j = 0; j < 4; ++j) {
      v[j] = *(const float4*)(xr + j * 256 + lane * 4);
      ss += v[j].x * v[j].x + v[j].y * v[j].y + v[j].z * v[j].z + v[j].w * v[j].w;
    }
    ss = wave_sum(ss);
    const float rs = rsqrtf(ss * (1.f / DM) + EPSF);
#pragma unroll
    for (int j = 0; j < 4; ++j) {
      float4 o = {v[j].x * rs * g[j].x, v[j].y * rs * g[j].y, v[j].z * rs * g[j].z, v[j].w * rs * g[j].w};
      *(float4*)(xr + j * 256 + lane * 4) = o;
    }
  }
}

struct PostArgs {
  u16* z; u16* ka;
  const float *qn, *kvn, *gq, *gk, *gv;
  const float *cosA, *sinA, *cosB, *sinB;
};
DI void post_phase(const PostArgs& a) {
  const int t = tid_opaque();
  const int lane = t & 63, l32 = lane & 31, hh = lane >> 5;
  const int wid = blockIdx.x * NWAVE + (t >> 6), nw = gridDim.x * NWAVE;
  const float qscale = 0.125f * LOG2E;
  for (int tok = wid; tok < NTOK; tok += nw) {
    u16* zr = a.z + (size_t)tok * DIN;
    const int s = tok & (SEQ - 1);
    uint2 cq = *(const uint2*)(zr + lane * 4);
    unsigned ckv = *(const unsigned*)(zr + 256 + lane * 2);
    unsigned kr = *(const unsigned*)(zr + 384 + (lane & 15) * 2);
    unsigned gq[3];
#pragma unroll
    for (int it = 0; it < 3; ++it) gq[it] = *(const unsigned*)(zr + 416 + (it * 2 + hh) * 64 + l32 * 2);
    unsigned gk = *(const unsigned*)(zr + 800 + hh * 64 + l32 * 2);
    uint4 gm = *(const uint4*)(zr + 1056 + lane * 8);
    {
      float v0 = bflo(cq.x), v1 = bfhi(cq.x), v2 = bflo(cq.y), v3 = bfhi(cq.y);
      float ss = wave_sum(v0 * v0 + v1 * v1 + v2 * v2 + v3 * v3);
      float rs = rsqrtf(ss * (1.f / 256.f) + EPSF);
      float4 g = *(const float4*)(a.qn + lane * 4);
      uint2 o = {pk2(v0 * rs * g.x, v1 * rs * g.y), pk2(v2 * rs * g.z, v3 * rs * g.w)};
      *(uint2*)(zr + lane * 4) = o;
    }
    {
      float v0 = bflo(ckv), v1 = bfhi(ckv);
      float ss = wave_sum(v0 * v0 + v1 * v1);
      float rs = rsqrtf(ss * (1.f / 128.f) + EPSF);
      float2 g = *(const float2*)(a.kvn + lane * 2);
      *(unsigned*)(zr + 256 + lane * 2) = pk2(v0 * rs * g.x, v1 * rs * g.y);
    }
    if (lane < 16) {
      float x0 = bflo(kr), x1 = bfhi(kr);
      float c = a.cosA[s * 16 + lane], sn = a.sinA[s * 16 + lane];
      unsigned o = pk2(x0 * c - x1 * sn, x0 * sn + x1 * c);
#pragma unroll
      for (int hd = 0; hd < 6; ++hd) *(unsigned*)(a.ka + (size_t)tok * 576 + hd * 96 + 64 + lane * 2) = o;
    }
    {
      float2 g = *(const float2*)(a.gq + l32 * 2);
      float c = a.cosB[s * 32 + l32], sn = a.sinB[s * 32 + l32];
#pragma unroll
      for (int it = 0; it < 3; ++it) {
        float v0 = bflo(gq[it]), v1 = bfhi(gq[it]);
        float ss = half_sum(v0 * v0 + v1 * v1);
        float rs = rsqrtf(ss * (1.f / 64.f) + EPSF);
        v0 *= rs * g.x; v1 *= rs * g.y;
        *(unsigned*)(zr + 416 + (it * 2 + hh) * 64 + l32 * 2) = pk2((v0 * c - v1 * sn) * qscale, (v0 * sn + v1 * c) * qscale);
      }
      float2 g2 = *(const float2*)(a.gk + l32 * 2);
      float v0 = bflo(gk), v1 = bfhi(gk);
      float ss = half_sum(v0 * v0 + v1 * v1);
      float rs = rsqrtf(ss * (1.f / 64.f) + EPSF);
      v0 *= rs * g2.x; v1 *= rs * g2.y;
      *(unsigned*)(zr + 800 + hh * 64 + l32 * 2) = pk2(v0 * c - v1 * sn, v0 * sn + v1 * c);
    }
    {
      float v[8] = {bflo(gm.x), bfhi(gm.x), bflo(gm.y), bfhi(gm.y), bflo(gm.z), bfhi(gm.z), bflo(gm.w), bfhi(gm.w)};
      float ss = 0.f;
#pragma unroll
      for (int j = 0; j < 8; ++j) { v[j] = gelu_tanh(v[j]); ss += v[j] * v[j]; }
      ss = hh ? ss : 0.f;
      ss = wave_sum(ss);
      float rs = rsqrtf(ss * (1.f / 256.f) + EPSF);
      if (hh) {
        float4 g0 = *(const float4*)(a.gv + l32 * 8), g1 = *(const float4*)(a.gv + l32 * 8 + 4);
        v[0] *= rs * g0.x; v[1] *= rs * g0.y; v[2] *= rs * g0.z; v[3] *= rs * g0.w;
        v[4] *= rs * g1.x; v[5] *= rs * g1.y; v[6] *= rs * g1.z; v[7] *= rs * g1.w;
      }
      uint4 o = {pk2(v[0], v[1]), pk2(v[2], v[3]), pk2(v[4], v[5]), pk2(v[6], v[7])};
      *(uint4*)(zr + 1056 + lane * 8) = o;
    }
  }
}

DI void outnorm_rows(const u16* __restrict__ y, const float* __restrict__ gain, u16* __restrict__ out, int row0) {
  const int t = tid_opaque();
  const int lane = t & 63;
  const int rbeg = row0 + (t >> 6) * 32;
  const int seg = lane < 24 ? 0 : (lane < 48 ? 1 : 2);
  float g[16];
#pragma unroll
  for (int j = 0; j < 4; ++j) {
    float4 t4 = *(const float4*)(gain + lane * 16 + j * 4);
    g[j * 4] = t4.x; g[j * 4 + 1] = t4.y; g[j * 4 + 2] = t4.z; g[j * 4 + 3] = t4.w;
  }
  for (int r = rbeg; r < rbeg + 32; ++r) {
    const u16* yr = y + (size_t)r * DM + lane * 16;
    uint4 a = *(const uint4*)yr, b = *(const uint4*)(yr + 8);
    float v[16] = {bflo(a.x), bfhi(a.x), bflo(a.y), bfhi(a.y), bflo(a.z), bfhi(a.z), bflo(a.w), bfhi(a.w),
                   bflo(b.x), bfhi(b.x), bflo(b.y), bfhi(b.y), bflo(b.z), bfhi(b.z), bflo(b.w), bfhi(b.w)};
    float ss = 0.f;
#pragma unroll
    for (int j = 0; j < 16; ++j) ss += v[j] * v[j];
    float s0 = wave_sum(seg == 0 ? ss : 0.f), s1 = wave_sum(seg == 1 ? ss : 0.f), s2 = wave_sum(seg == 2 ? ss : 0.f);
    float rs = seg == 0 ? rsqrtf(s0 * (1.f / 384.f) + EPSF) : (seg == 1 ? rsqrtf(s1 * (1.f / 384.f) + EPSF) : rsqrtf(s2 * (1.f / 256.f) + EPSF));
#pragma unroll
    for (int j = 0; j < 16; ++j) v[j] *= rs * g[j];
    uint4 o0 = {pk2(v[0], v[1]), pk2(v[2], v[3]), pk2(v[4], v[5]), pk2(v[6], v[7])};
    uint4 o1 = {pk2(v[8], v[9]), pk2(v[10], v[11]), pk2(v[12], v[13]), pk2(v[14], v[15])};
    u16* orow = out + (size_t)r * DM + lane * 16;
    *(uint4*)orow = o0; *(uint4*)(orow + 8) = o1;
  }
}

enum { EPI_BF16 = 0, EPI_QA = 1, EPI_KVA = 2, EPI_RESID = 3 };
struct GemmArgs {
  const u16* A; int lda;
  const u16* W; int ldw;
  int M, N, K, epi;
  u16* out; int ldo; float scale;
  u16* out2;
  const float* res; float* outf;
  const float *cosA, *sinA;
  const float *convw, *convb;
};
constexpr int G_ROW = 128;
constexpr int G_STAGE = (256 + 256) * G_ROW;
constexpr int FFN_MT_PER_SEQ = 33;

template <bool FFN>
DI void gemm_tile(const GemmArgs& g, int mt, int nt, char* smem) {
  const int t = tid_opaque(), lane = t & 63, w = t >> 6, l32 = lane & 31, h = lane >> 5;
  const int wm_ = w >> 2, wn_ = w & 3;
  const int m0 = mt * 256, n0 = nt * 256;
  const int prw = lane >> 3, pslot = lane & 7;
  const u16* asrc[4]; const u16* wsrc[4];
#pragma unroll
  for (int i = 0; i < 4; ++i) {
    const int r = (w * 4 + i) * 8 + prw;
    const int gr = pslot ^ ((r >> 1) & 7);
    size_t grow;
    if (FFN) {
      const int b = mt / FFN_MT_PER_SEQ, ti = mt % FFN_MT_PER_SEQ;
      int tok = ti * 252 - 1 + r - (r >= 128 ? 2 : 0);
      tok = tok < 0 ? 0 : (tok >= SEQ ? SEQ - 1 : tok);
      grow = (size_t)b * SEQ + tok;
    } else grow = (size_t)m0 + r;
    asrc[i] = g.A + grow * g.lda + gr * 8;
    int n = n0 + r; n = n < g.N ? n : 0;
    wsrc[i] = g.W + (size_t)n * g.ldw + gr * 8;
  }
  int nv = (g.N - (n0 + wn_ * 64)) >> 5;
  nv = nv < 0 ? 0 : (nv > 2 ? 2 : nv);
  nv = __builtin_amdgcn_readfirstlane(nv);

  f32x16 acc[4][2];
#pragma unroll
  for (int mi = 0; mi < 4; ++mi)
#pragma unroll
    for (int ni = 0; ni < 2; ++ni)
#pragma unroll
      for (int r = 0; r < 16; ++r) acc[mi][ni][r] = 0.f;

  const int nk = g.K >> 6;
  const unsigned lds_w = __builtin_amdgcn_readfirstlane((unsigned)(size_t)smem + (unsigned)(w * 4096));
  const int sw = (l32 >> 1) & 7;
  const char* const fr_a = smem + (wm_ * 128 + l32) * G_ROW;
  const char* const fr_w = smem + 256 * G_ROW + (wn_ * 64 + l32) * G_ROW;

#define G_DMA(kt, stg)                                                          \
  {                                                                             \
    _Pragma("unroll") for (int i = 0; i < 4; ++i) {                             \
      glds16(asrc[i] + (kt) * 64, lds_w + (stg) * G_STAGE + i * 1024);          \
      glds16(wsrc[i] + (kt) * 64, lds_w + (stg) * G_STAGE + 256 * G_ROW + i * 1024); \
    }                                                                           \
  }
#define G_COMPUTE_N(stg, NIV)                                                   \
  {                                                                             \
    _Pragma("unroll") for (int k2 = 0; k2 < 4; k2 += 2) {                       \
      bf16x8 af[2][4], wf[2][2];                                                \
      _Pragma("unroll") for (int u = 0; u < 2; ++u) {                           \
        const int ko = (((k2 + u) * 2 + h) ^ sw) * 16;                          \
        wf[u][0] = *(const bf16x8*)(fr_w + (stg) * G_STAGE + ko);               \
        _Pragma("unroll") for (int mi = 0; mi < 4; ++mi) af[u][mi] = *(const bf16x8*)(fr_a + (stg) * G_STAGE + mi * 32 * G_ROW + ko); \
        if (NIV > 1) wf[u][1] = *(const bf16x8*)(fr_w + (stg) * G_STAGE + 32 * G_ROW + ko);  \
      }                                                                         \
      __builtin_amdgcn_sched_barrier(0);                                        \
      _Pragma("unroll") for (int u = 0; u < 2; ++u) {                           \
        _Pragma("unroll") for (int ni = 0; ni < NIV; ++ni) {                    \
          _Pragma("unroll") for (int mi = 0; mi < 4; ++mi) {                    \
            if (FFN) acc[mi][ni] = MFMA(af[u][mi], wf[u][ni], acc[mi][ni]);     \
            else     acc[mi][ni] = MFMA(wf[u][ni], af[u][mi], acc[mi][ni]);     \
          }                                                                     \
        }                                                                       \
      }                                                                         \
      __builtin_amdgcn_sched_barrier(0);                                        \
    }                                                                           \
  }

  __builtin_amdgcn_s_waitcnt(0x0F70);
  G_DMA(0, 0);
  VM_WAIT(0);
  __syncthreads();
#define G_KLOOP(NIV)                                                            \
  for (int kt = 0; kt < nk; kt += 2) {                                          \
    G_DMA(kt + 1, 1);                                 \
    if (NIV > 0) G_COMPUTE_N(0, (NIV > 0 ? NIV : 1));                           \
    VM_WAIT(0);                                                                 \
    __syncthreads();                                                            \
    if (kt + 2 < nk) G_DMA(kt + 2, 0);                                          \
    if (NIV > 0) G_COMPUTE_N(1, (NIV > 0 ? NIV : 1));                           \
    VM_WAIT(0);                                                                 \
    __syncthreads();                                                            \
  }
  if (nv == 2) { G_KLOOP(2) } else if (nv == 1) { G_KLOOP(1) } else { G_KLOOP(0) }
#undef G_KLOOP
#undef G_COMPUTE_N
#undef G_DMA

  if (FFN) {
    const int ch = (nt * 4 + wn_) * 32 + l32;
    const float* cw = g.convw;
    const float gw0 = cw[ch], gw1 = cw[2 * DFF + ch], gw2 = cw[4 * DFF + ch], gb = g.convb[ch];
    const float vw0 = cw[DFF + ch], vw1 = cw[3 * DFF + ch], vw2 = cw[5 * DFF + ch], vb = g.convb[DFF + ch];
    const int b = mt / FFN_MT_PER_SEQ, ti = mt % FFN_MT_PER_SEQ;
    const int tok0 = ti * 252 - 1 + wm_ * 126;
#pragma unroll
    for (int mi = 0; mi < 4; ++mi)
#pragma unroll
      for (int q = 0; q < 4; ++q)
#pragma unroll
        for (int e = 0; e < 4; ++e) {
          const bool okr = (unsigned)(tok0 + mi * 32 + q * 8 + h * 4 + e) < (unsigned)SEQ;
          acc[mi][0][q * 4 + e] = okr ? acc[mi][0][q * 4 + e] : 0.f;
          acc[mi][1][q * 4 + e] = okr ? acc[mi][1][q * 4 + e] : 0.f;
        }
    float pprev0 = 0.f, pprev1 = 0.f;
    float ncur0 = xhalf(acc[0][0][0], h), ncur1 = xhalf(acc[0][1][0], h);
#pragma unroll
    for (int gi = 0; gi < 16; ++gi) {
      const int mi = gi >> 2, q = gi & 3;
      float a0 = acc[mi][0][q * 4], a1 = acc[mi][0][q * 4 + 1], a2 = acc[mi][0][q * 4 + 2], a3 = acc[mi][0][q * 4 + 3];
      float b0 = acc[mi][1][q * 4], b1 = acc[mi][1][q * 4 + 1], b2 = acc[mi][1][q * 4 + 2], b3 = acc[mi][1][q * 4 + 3];
      float pg0 = xhalf(a3, h), pg1 = xhalf(b3, h);
      float nn0 = 0.f, nn1 = 0.f;
      if (gi < 15) {
        const int mi2 = (gi + 1) >> 2, q2 = (gi + 1) & 3;
        nn0 = xhalf(acc[mi2][0][q2 * 4], h);
        nn1 = xhalf(acc[mi2][1][q2 * 4], h);
      }
      float pa = h ? pg0 : pprev0, pb = h ? pg1 : pprev1;
      float na = h ? nn0 : ncur0, nb = h ? nn1 : ncur1;
      pprev0 = pg0; pprev1 = pg1; ncur0 = nn0; ncur1 = nn1;
      float cg[4], cv[4];
      cg[0] = gw0 * pa + gw1 * a0 + gw2 * a1 + gb;
      cg[1] = gw0 * a0 + gw1 * a1 + gw2 * a2 + gb;
      cg[2] = gw0 * a1 + gw1 * a2 + gw2 * a3 + gb;
      cg[3] = gw0 * a2 + gw1 * a3 + gw2 * na + gb;
      cv[0] = vw0 * pb + vw1 * b0 + vw2 * b1 + vb;
      cv[1] = vw0 * b0 + vw1 * b1 + vw2 * b2 + vb;
      cv[2] = vw0 * b1 + vw1 * b2 + vw2 * b3 + vb;
      cv[3] = vw0 * b2 + vw1 * b3 + vw2 * nb + vb;
      float sv[4];
#pragma unroll
      for (int e = 0; e < 4; ++e) {
        const float gt = cg[e];
        sv[e] = gt * __builtin_amdgcn_rcpf(1.f + __expf(-gt)) * cv[e];
      }
      {
        const int odd = l32 & 1;
        const float r0 = dpp_xor1(odd ? sv[0] : sv[2]), r1 = dpp_xor1(odd ? sv[1] : sv[3]);
        const unsigned w0 = odd ? pk2(r0, sv[2]) : pk2(sv[0], r0);
        const unsigned w1 = odd ? pk2(r1, sv[3]) : pk2(sv[1], r1);
        const int rowb = wm_ * 128 + mi * 32 + q * 8 + h * 4 + odd * 2;
        char* tp = smem + rowb * 272 + (wn_ * 32 + (l32 & ~1)) * 2;
        *(unsigned*)tp = w0;
        *(unsigned*)(tp + 272) = w1;
      }
      __builtin_amdgcn_sched_barrier(0);
    }
    __syncthreads();
    {
      const int chb = nt * 128;
#pragma unroll
      for (int i = 0; i < 8; ++i) {
        const int c = t + i * NTHR, row = c >> 4, cc = c & 15;
        const int lr = row & 127;
        const int tok = ti * 252 - 1 + (row >> 7) * 126 + lr;
        const uint4 v = *(const uint4*)(smem + row * 272 + cc * 16);
        if (lr >= 1 && lr <= 126 && tok < SEQ) *(uint4*)(g.out + (size_t)(b * SEQ + tok) * DFF + chb + cc * 8) = v;
      }
    }
    __syncthreads();
  } else {
#pragma unroll
    for (int mi = 0; mi < 4; ++mi) {
      const int m = m0 + wm_ * 128 + mi * 32 + l32;
#pragma unroll
      for (int ni = 0; ni < 2; ++ni) {
        if (ni < nv && g.epi == EPI_KVA) {
#pragma unroll
          for (int q = 0; q < 4; q += 2) {
            const int nb = n0 + wn_ * 64 + ni * 32 + q * 8;
            const int hd = nb >> 7, within = nb & 127;
            uint2 a = {pk2(acc[mi][ni][q * 4], acc[mi][ni][q * 4 + 1]), pk2(acc[mi][ni][q * 4 + 2], acc[mi][ni][q * 4 + 3])};
            uint2 b = {pk2(acc[mi][ni][q * 4 + 4], acc[mi][ni][q * 4 + 5]), pk2(acc[mi][ni][q * 4 + 6], acc[mi][ni][q * 4 + 7])};
            u16* dst = (within < 64) ? g.out + (size_t)m * 576 + hd * 96 + within : g.out2 + (size_t)m * 384 + hd * 64 + within - 64;
            store_pair16(dst, a, b, h);
          }
        } else if (ni < nv && (g.epi == EPI_BF16 || g.epi == EPI_QA)) {
          uint2 pkd[4];
#pragma unroll
          for (int q = 0; q < 4; ++q) {
            const int n = n0 + wn_ * 64 + ni * 32 + q * 8 + h * 4;
            float v0 = acc[mi][ni][q * 4], v1 = acc[mi][ni][q * 4 + 1], v2 = acc[mi][ni][q * 4 + 2], v3 = acc[mi][ni][q * 4 + 3];
            if (g.epi == EPI_QA) {
              const int within = n % 96;
              if (within >= 64) {
                const int s = m & (SEQ - 1), pi = (within - 64) >> 1;
                float c0 = g.cosA[s * 16 + pi], s0 = g.sinA[s * 16 + pi], c1 = g.cosA[s * 16 + pi + 1], s1 = g.sinA[s * 16 + pi + 1];
                float t0 = v0 * c0 - v1 * s0, t1 = v0 * s0 + v1 * c0, t2 = v2 * c1 - v3 * s1, t3 = v2 * s1 + v3 * c1;
                v0 = t0; v1 = t1; v2 = t2; v3 = t3;
              }
            }
            pkd[q].x = pk2(v0 * g.scale, v1 * g.scale); pkd[q].y = pk2(v2 * g.scale, v3 * g.scale);
          }
          u16* rowp = g.out + (size_t)m * g.ldo + n0 + wn_ * 64 + ni * 32;
          store_pair16(rowp, pkd[0], pkd[1], h);
          store_pair16(rowp + 16, pkd[2], pkd[3], h);
        } else if (ni < nv) {
#pragma unroll
          for (int q = 0; q < 4; ++q) {
            const int n = n0 + wn_ * 64 + ni * 32 + q * 8 + h * 4;
            float v0 = acc[mi][ni][q * 4], v1 = acc[mi][ni][q * 4 + 1], v2 = acc[mi][ni][q * 4 + 2], v3 = acc[mi][ni][q * 4 + 3];
            if (g.epi == EPI_QA) {
              const int within = n % 96;
              if (within >= 64) {
                const int s = m & (SEQ - 1), pi = (within - 64) >> 1;
                float c0 = g.cosA[s * 16 + pi], s0 = g.sinA[s * 16 + pi], c1 = g.cosA[s * 16 + pi + 1], s1 = g.sinA[s * 16 + pi + 1];
                float t0 = v0 * c0 - v1 * s0, t1 = v0 * s0 + v1 * c0, t2 = v2 * c1 - v3 * s1, t3 = v2 * s1 + v3 * c1;
                v0 = t0; v1 = t1; v2 = t2; v3 = t3;
              }
              uint2 o = {pk2(v0 * g.scale, v1 * g.scale), pk2(v2 * g.scale, v3 * g.scale)};
              *(uint2*)(g.out + (size_t)m * 576 + n) = o;
            } else if (g.epi == EPI_KVA) {
              const int hd = n >> 7, within = n & 127;
              uint2 o = {pk2(v0, v1), pk2(v2, v3)};
              if (within < 64) *(uint2*)(g.out + (size_t)m * 576 + hd * 96 + within) = o;
              else *(uint2*)(g.out2 + (size_t)m * 384 + hd * 64 + within - 64) = o;
            } else {
              float4 r = *(const float4*)(g.res + (size_t)m * DM + n);
              float4 o = {r.x + v0, r.y + v1, r.z + v2, r.w + v3};
              *(float4*)(g.outf + (size_t)m * DM + n) = o;
            }
          }
        }
        __builtin_amdgcn_sched_barrier(0);
      }
    }
  }
}

template <bool FFN>
DI void gemm_phase(const GemmArgs& g, char* smem) {
  const int MT = FFN ? NB * FFN_MT_PER_SEQ : g.M / 256;
  const int NT = (g.N + 255) / 256;
  const int njobs = MT * NT;
  const int MTx = MT >> 3;
  const int ngf = NT >> 2, jfull = MTx * 4;
  for (int j = blockIdx.x; j < njobs; j += gridDim.x) {
    const int x = j & 7, jj = j >> 3;
    int ng, rem, gn;
    if (jj < ngf * jfull) { ng = jj / jfull; rem = jj - ng * jfull; gn = 4; }
    else { ng = ngf; rem = jj - ngf * jfull; gn = NT & 3; }
    const int ml = rem / gn, nin = rem - ml * gn;
    const int mt = x + 8 * ml, nt = ng * 4 + nin;
    gemm_tile<FFN>(g, mt, nt, smem);
  }
}

DI float max3f(float a, float b, float c) { return fmaxf(fmaxf(a, b), c); }
DI float xhalf_max(float v) {
  auto r = __builtin_amdgcn_permlane32_swap(__float_as_uint(v), __float_as_uint(v), false, false);
  return fmaxf(__uint_as_float(r[0]), __uint_as_float(r[1]));
}
DI int prow(int i) { return (i & ~12) | ((i & 4) << 1) | ((i & 8) >> 1); }

template <int DK, int DV>
DI void attn_block(const u16* __restrict__ Q, int ldq, const u16* __restrict__ K, int ldk, const u16* __restrict__ V, int ldv,
                   u16* __restrict__ O, int ldo, int T, char* smem) {
  constexpr int KS = DK * 2 + 16, VS = DV * 2 + 64;
  constexpr int TK = (DK <= 96 && DV <= 64) ? 128 : 64;
  constexpr int NKB = TK / 32, NC = TK / 16;
  constexpr int KT = TK * KS, STG = KT + TK * VS;
  constexpr int KCH = DK / 8, VCH = DV / 8;
  constexpr int NK = (TK * KCH + NTHR - 1) / NTHR, NV = (TK * VCH + NTHR - 1) / NTHR;
  const int t = tid_opaque(), lane = t & 63, w = t >> 6, l32 = lane & 31, h = lane >> 5;

  bf16x8 qf[DK / 16];
#pragma unroll
  for (int kc = 0; kc < DK / 16; ++kc) qf[kc] = *(const bf16x8*)(Q + (size_t)(w * 32 + l32) * ldq + kc * 16 + h * 8);
#pragma unroll
  for (int kc = 0; kc < DK / 16; ++kc) asm volatile("" ::"v"(qf[kc]));

  f32x16 o[DV / 32];
#pragma unroll
  for (int d = 0; d < DV / 32; ++d)
#pragma unroll
    for (int r = 0; r < 16; ++r) o[d][r] = 0.f;
  float mref = 0.f;
  f32x16 negm;
#pragma unroll
  for (int r = 0; r < 16; ++r) negm[r] = 0.f;

  u32x4 rk[NK], rv[NV];
  const u16* kp[NK]; const u16* vp[NV];
  int ksto[NK], vsto[NV];
#pragma unroll
  for (int i = 0; i < NK; ++i) {
    int c = t + i * NTHR; if (c >= TK * KCH) c -= NTHR;
    int row = c / KCH, kc = c % KCH;
    kp[i] = K + (size_t)row * ldk + kc * 8;
    ksto[i] = row * KS + kc * 16;
  }
#pragma unroll
  for (int i = 0; i < NV; ++i) {
    int c = t + i * NTHR; if (c >= TK * VCH) c -= NTHR;
    int row = c / VCH, vc = c % VCH;
    vp[i] = V + (size_t)row * ldv + vc * 8;
    vsto[i] = KT + row * VS + vc * 16;
  }
#define A_LOAD(kt)                                                                                          \
  {                                                                                                         \
    _Pragma("unroll") for (int i = 0; i < NK; ++i) gload16(rk[i], kp[i] + (size_t)(kt) * TK * ldk); \
    _Pragma("unroll") for (int i = 0; i < NV; ++i) gload16(rv[i], vp[i] + (size_t)(kt) * TK * ldv); \
  }
#define A_STORE(stg)                                                                           \
  {                                                                                            \
    _Pragma("unroll") for (int i = 0; i < NK; ++i) *(u32x4*)(smem + (stg) * STG + ksto[i]) = rk[i]; \
    _Pragma("unroll") for (int i = 0; i < NV; ++i) *(u32x4*)(smem + (stg) * STG + vsto[i]) = rv[i]; \
  }
  const int nt = T / TK;
  const int kfr0 = prow(l32) * KS + h * 16;
  const int qq = (lane & 15) >> 2, pp = lane & 3, blk = (lane >> 4) & 1;
  const int vfr0 = KT + (8 * h + qq) * VS + blk * 32 + pp * 8;

#define A_TIE() { _Pragma("unroll") for (int i = 0; i < NK; ++i) TIE(rk[i]); _Pragma("unroll") for (int i = 0; i < NV; ++i) TIE(rv[i]); }
  __builtin_amdgcn_s_waitcnt(0x0F70);
  A_LOAD(0);
  VM_WAIT(0);
  A_TIE();
  A_STORE(0);
  __syncthreads();
  float lrun = 0.f;
  for (int kt = 0; kt < nt; ++kt) {
    const int stg = kt & 1;
    { const int ktn = (kt + 1 < nt) ? kt + 1 : kt; A_LOAD(ktn); }
    __builtin_amdgcn_sched_barrier(0);
    const char* sb = smem + stg * STG;
    f32x16 s[NKB];
#pragma unroll
    for (int kb2 = 0; kb2 < NKB; kb2 += 2) {
      bf16x8 kf[2][DK / 16];
#pragma unroll
      for (int kc = 0; kc < DK / 16; ++kc)
#pragma unroll
        for (int u = 0; u < 2; ++u) kf[u][kc] = *(const bf16x8*)(sb + kfr0 + (kb2 + u) * 32 * KS + kc * 32);
      s[kb2] = MFMA(kf[0][0], qf[0], negm);
      s[kb2 + 1] = MFMA(kf[1][0], qf[0], negm);
#pragma unroll
      for (int kc = 1; kc < DK / 16; ++kc) {
        s[kb2] = MFMA(kf[0][kc], qf[kc], s[kb2]);
        s[kb2 + 1] = MFMA(kf[1][kc], qf[kc], s[kb2 + 1]);
      }
    }
    float mx = max3f(s[0][0], s[0][1], s[0][2]);
#pragma unroll
    for (int r = 3; r < 15; r += 2) mx = max3f(mx, s[0][r], s[0][r + 1]);
    mx = fmaxf(mx, s[0][15]);
#pragma unroll
    for (int kb = 1; kb < NKB; ++kb) {
#pragma unroll
      for (int r = 0; r < 16; r += 2) mx = max3f(mx, s[kb][r], s[kb][r + 1]);
    }
    mx = xhalf_max(mx);
    if (kt == 0 || __builtin_amdgcn_ballot_w64(mx > 8.0f) != 0ull) {
      const float delta = (kt == 0) ? mx : fmaxf(mx, 0.f);
      const float alpha = (kt == 0) ? 1.f : __builtin_amdgcn_exp2f(-delta);
      mref += delta;
#pragma unroll
      for (int r = 0; r < 16; ++r) negm[r] = -mref;
      lrun *= alpha;
#pragma unroll
      for (int d = 0; d < DV / 32; ++d)
#pragma unroll
        for (int r = 0; r < 16; ++r) o[d][r] *= alpha;
#pragma unroll
      for (int kb = 0; kb < NKB; ++kb)
#pragma unroll
        for (int r = 0; r < 16; ++r) s[kb][r] -= delta;
    }
#define AT_EXPCVT(kb, PF)                                                                              \
    {                                                                                                  \
      _Pragma("unroll") for (int u = 0; u < 2; ++u) {                                                  \
        float e_[8];                                                                                   \
        _Pragma("unroll") for (int j = 0; j < 8; ++j) { e_[j] = __builtin_amdgcn_exp2f(s[kb][u * 8 + j]); lrun += e_[j]; } \
        uint4 pu_ = {pk2(e_[0], e_[1]), pk2(e_[2], e_[3]), pk2(e_[4], e_[5]), pk2(e_[6], e_[7])};      \
        PF[u] = __builtin_bit_cast(bf16x8, pu_);                                                       \
      }                                                                                                \
    }
#define AT_READV(kb, VF)                                                                               \
    {                                                                                                  \
      _Pragma("unroll") for (int u = 0; u < 2; ++u)                                                    \
        _Pragma("unroll") for (int d = 0; d < DV / 32; ++d) {                                          \
          const char* va = sb + vfr0 + ((kb) * 2 + u) * 16 * VS + d * 64;                              \
          s16x4 lo = __builtin_amdgcn_ds_read_tr16_b64_v4i16((lds_s16x4*)(va));                        \
          s16x4 hi = __builtin_amdgcn_ds_read_tr16_b64_v4i16((lds_s16x4*)(va + 4 * VS));              \
          VF[u][d] = __builtin_shufflevector(lo, hi, 0, 1, 2, 3, 4, 5, 6, 7);                          \
        }                                                                                              \
    }
#define AT_PVM(PF, VF)                                                                                 \
    {                                                                                                  \
      _Pragma("unroll") for (int u = 0; u < 2; ++u) {                                                  \
        _Pragma("unroll") for (int d = 0; d < DV / 32; ++d) o[d] = MFMA(VF[u][d], PF[u], o[d]);        \
      }                                                                                                \
    }
#define AT_SCHED_STAGE()     \
    {                                                                                                  \
      _Pragma("unroll") for (int i_ = 0; i_ < 2 * (DV / 32); ++i_) {                                     \
        __builtin_amdgcn_sched_group_barrier(0x008, 1, 0);                                             \
        __builtin_amdgcn_sched_group_barrier(0x002, (DV == 64) ? 10 : 5, 0);                           \
        __builtin_amdgcn_sched_group_barrier(0x100, 2, 0);                                             \
      }                                                                                                \
    }
    {
      bf16x8 pfA[2], pfB[2], vfA[2][DV / 32], vfB[2][DV / 32];
      AT_EXPCVT(0, pfA);
      AT_READV(0, vfA);
#pragma unroll
      for (int kb = 0; kb < NKB; kb += 2) {
        AT_EXPCVT(kb + 1, pfB);
        AT_READV(kb + 1, vfB);
        AT_PVM(pfA, vfA);
        if (kb + 2 < NKB) {
          AT_EXPCVT(kb + 2, pfA);
          AT_READV(kb + 2, vfA);
        }
        AT_PVM(pfB, vfB);
      }
      __builtin_amdgcn_sched_group_barrier(0x002, 44, 0);
      __builtin_amdgcn_sched_group_barrier(0x100, 4 * (DV / 32), 0);
#pragma unroll
      for (int st_ = 0; st_ < NKB - 1; ++st_) AT_SCHED_STAGE();
      __builtin_amdgcn_sched_group_barrier(0x008, 2 * (DV / 32), 0);
    }
#undef AT_EXPCVT
#undef AT_READV
#undef AT_PVM
#undef AT_SCHED_STAGE
    VM_WAIT(0);
    A_TIE();
    A_STORE(stg ^ 1);
    __syncthreads();
  }
#undef A_TIE
#undef A_LOAD
#undef A_STORE
  const float inv = 1.f / (lrun + xhalf(lrun, h));
  u16* orow = O + (size_t)(w * 32 + l32) * ldo;
#pragma unroll
  for (int d = 0; d < DV / 32; ++d)
#pragma unroll
    for (int q = 0; q < 4; q += 2) {
      uint2 oa = {pk2(o[d][q * 4] * inv, o[d][q * 4 + 1] * inv), pk2(o[d][q * 4 + 2] * inv, o[d][q * 4 + 3] * inv)};
      uint2 ob = {pk2(o[d][q * 4 + 4] * inv, o[d][q * 4 + 5] * inv), pk2(o[d][q * 4 + 6] * inv, o[d][q * 4 + 7] * inv)};
      store_pair16(orow + d * 32 + q * 8, oa, ob, h);
    }
}

template <int DK>
DI void attn_block_dma(const u16* __restrict__ Q, int ldq, const u16* __restrict__ K, int ldk, const u16* __restrict__ V, int ldv,
                   u16* __restrict__ O, int ldo, int T, char* smem) {
  constexpr int DV = 64, TK = 128, NKB = 4;
  constexpr int KBY = DK * 2, KG = DK / 8;
  constexpr int KT = TK * KBY, STG = KT + TK * 128;
  constexpr int NKP = KT / 1024, NPW = (NKP + 16) / 8;
  static_assert(2 * STG <= 2 * G_STAGE, "LDS");
  const int t = tid_opaque(), lane = t & 63, w = t >> 6, l32 = lane & 31, h = lane >> 5;


  f32x16 o[DV / 32];
#pragma unroll
  for (int d = 0; d < DV / 32; ++d)
#pragma unroll
    for (int r = 0; r < 16; ++r) o[d][r] = 0.f;
  float mref = 0.f;
  f32x16 negm;
#pragma unroll
  for (int r = 0; r < 16; ++r) negm[r] = 0.f;

  const u16* psrc[NPW]; unsigned pdst[NPW];
  const unsigned lds0 = (unsigned)(size_t)smem;
#pragma unroll
  for (int i = 0; i < NPW; ++i) {
    const int pz = w + 8 * i;
    if (i * 8 < NKP) {
      const int S = pz * 64 + lane, r = S / KG, slot = S % KG;
      const int gg = (DK == 64) ? (slot ^ ((r >> 1) & 7)) : ((slot + 12 - ((r >> 2) & 3)) % 12);
      psrc[i] = K + (size_t)r * ldk + gg * 8;
      pdst[i] = pz * 1024;
    } else {
      const int S = (pz - NKP) * 64 + lane, r = S >> 3, slot = S & 7;
      const int gg = slot ^ (((r >> 1) & 1) << 2);
      psrc[i] = V + (size_t)r * ldv + gg * 8;
      pdst[i] = KT + (pz - NKP) * 1024;
    }
  }
#define A_DMA(kt, stg)                                                                        \
  {                                                                                           \
    _Pragma("unroll") for (int i = 0; i < NPW; ++i)                                           \
      glds16(psrc[i] + (size_t)(kt) * TK * ((i * 8 < NKP) ? ldk : ldv),                       \
             __builtin_amdgcn_readfirstlane(lds0 + (stg) * STG + pdst[i]));                   \
  }
  const int nt = T / TK;
  const int krow = prow(l32);
  int kslot[DK / 16];
#pragma unroll
  for (int kc = 0; kc < DK / 16; ++kc) {
    if (DK == 64) kslot[kc] = ((kc * 2 + h) ^ ((krow >> 1) & 7)) * 16;
    else { const int tt = kc * 2 + h + ((krow >> 2) & 3); kslot[kc] = (tt >= 12 ? tt - 12 : tt) * 16; }
  }
  const int kfr0 = krow * KBY;
  const int qq = (lane & 15) >> 2, pp = lane & 3, blk = (lane >> 4) & 1;
  const int vxb = (qq >> 1) & 1;
  const int vfr0 = KT + (8 * h + qq) * 128 + (blk * 2 + (pp >> 1)) * 16 + (pp & 1) * 8;
  const int vd0 = vxb * 64, vd1 = (1 - vxb) * 64;

  __builtin_amdgcn_s_waitcnt(0x0F70);
  A_DMA(0, 0);
  bf16x8 qf[DK / 16];
#pragma unroll
  for (int kc = 0; kc < DK / 16; ++kc) qf[kc] = *(const bf16x8*)(Q + (size_t)(w * 32 + l32) * ldq + kc * 16 + h * 8);
#pragma unroll
  for (int kc = 0; kc < DK / 16; ++kc) asm volatile("" ::"v"(qf[kc]));
  VM_WAIT(0);
  __syncthreads();
  float lrun = 0.f;
  for (int kt = 0; kt < nt; ++kt) {
    const int stg = kt & 1;
    if (kt + 1 < nt) A_DMA(kt + 1, stg ^ 1);
    __builtin_amdgcn_sched_barrier(0);
    const char* sb = smem + stg * STG;
    f32x16 s[NKB];
#pragma unroll
    for (int kb2 = 0; kb2 < NKB; kb2 += 2) {
      bf16x8 kf[2][DK / 16];
#pragma unroll
      for (int kc = 0; kc < DK / 16; ++kc)
#pragma unroll
        for (int u = 0; u < 2; ++u) kf[u][kc] = *(const bf16x8*)(sb + kfr0 + (kb2 + u) * 32 * KBY + kslot[kc]);
      s[kb2] = MFMA(kf[0][0], qf[0], negm);
      s[kb2 + 1] = MFMA(kf[1][0], qf[0], negm);
#pragma unroll
      for (int kc = 1; kc < DK / 16; ++kc) {
        s[kb2] = MFMA(kf[0][kc], qf[kc], s[kb2]);
        s[kb2 + 1] = MFMA(kf[1][kc], qf[kc], s[kb2 + 1]);
      }
    }
    float mx = max3f(s[0][0], s[0][1], s[0][2]);
#pragma unroll
    for (int r = 3; r < 15; r += 2) mx = max3f(mx, s[0][r], s[0][r + 1]);
    mx = fmaxf(mx, s[0][15]);
#pragma unroll
    for (int kb = 1; kb < NKB; ++kb) {
#pragma unroll
      for (int r = 0; r < 16; r += 2) mx = max3f(mx, s[kb][r], s[kb][r + 1]);
    }
    mx = xhalf_max(mx);
    if (kt == 0 || __builtin_amdgcn_ballot_w64(mx > 8.0f) != 0ull) {
      const float delta = (kt == 0) ? mx : fmaxf(mx, 0.f);
      const float alpha = (kt == 0) ? 1.f : __builtin_amdgcn_exp2f(-delta);
      mref += delta;
#pragma unroll
      for (int r = 0; r < 16; ++r) negm[r] = -mref;
      lrun *= alpha;
#pragma unroll
      for (int d = 0; d < DV / 32; ++d)
#pragma unroll
        for (int r = 0; r < 16; ++r) o[d][r] *= alpha;
#pragma unroll
      for (int kb = 0; kb < NKB; ++kb)
#pragma unroll
        for (int r = 0; r < 16; ++r) s[kb][r] -= delta;
    }
#define AT_EXPCVT(kb, PF)                                                                              \
    {                                                                                                  \
      _Pragma("unroll") for (int u = 0; u < 2; ++u) {                                                  \
        float e_[8];                                                                                   \
        _Pragma("unroll") for (int j = 0; j < 8; ++j) { e_[j] = __builtin_amdgcn_exp2f(s[kb][u * 8 + j]); lrun += e_[j]; } \
        uint4 pu_ = {pk2(e_[0], e_[1]), pk2(e_[2], e_[3]), pk2(e_[4], e_[5]), pk2(e_[6], e_[7])};      \
        PF[u] = __builtin_bit_cast(bf16x8, pu_);                                                       \
      }                                                                                                \
    }
#define AT_READV(kb, VF)                                                                               \
    {                                                                                                  \
      _Pragma("unroll") for (int u = 0; u < 2; ++u)                                                    \
        _Pragma("unroll") for (int d = 0; d < DV / 32; ++d) {                                          \
          const char* va = sb + vfr0 + ((kb) * 2 + u) * 16 * 128 + (d ? vd1 : vd0);                    \
          s16x4 lo = __builtin_amdgcn_ds_read_tr16_b64_v4i16((lds_s16x4*)(va));                        \
          s16x4 hi = __builtin_amdgcn_ds_read_tr16_b64_v4i16((lds_s16x4*)(va + 4 * 128));             \
          VF[u][d] = __builtin_shufflevector(lo, hi, 0, 1, 2, 3, 4, 5, 6, 7);                          \
        }                                                                                              \
    }
#define AT_PVM(PF, VF)                                                                                 \
    {                                                                                                  \
      _Pragma("unroll") for (int u = 0; u < 2; ++u) {                                                  \
        _Pragma("unroll") for (int d = 0; d < DV / 32; ++d) o[d] = MFMA(VF[u][d], PF[u], o[d]);        \
      }                                                                                                \
    }
#define AT_SCHED_STAGE()     \
    {                                                                                                  \
      _Pragma("unroll") for (int i_ = 0; i_ < 2 * (DV / 32); ++i_) {                                     \
        __builtin_amdgcn_sched_group_barrier(0x008, 1, 0);                                             \
        __builtin_amdgcn_sched_group_barrier(0x002, (DV == 64) ? 10 : 5, 0);                           \
        __builtin_amdgcn_sched_group_barrier(0x100, 2, 0);                                             \
      }                                                                                                \
    }
    {
      bf16x8 pfA[2], pfB[2], vfA[2][DV / 32], vfB[2][DV / 32];
      AT_EXPCVT(0, pfA);
      AT_READV(0, vfA);
#pragma unroll
      for (int kb = 0; kb < NKB; kb += 2) {
        AT_EXPCVT(kb + 1, pfB);
        AT_READV(kb + 1, vfB);
        AT_PVM(pfA, vfA);
        if (kb + 2 < NKB) {
          AT_EXPCVT(kb + 2, pfA);
          AT_READV(kb + 2, vfA);
        }
        AT_PVM(pfB, vfB);
      }
      __builtin_amdgcn_sched_group_barrier(0x002, 44, 0);
      __builtin_amdgcn_sched_group_barrier(0x100, 4 * (DV / 32), 0);
#pragma unroll
      for (int st_ = 0; st_ < NKB - 1; ++st_) AT_SCHED_STAGE();
      __builtin_amdgcn_sched_group_barrier(0x008, 2 * (DV / 32), 0);
    }
#undef AT_EXPCVT
#undef AT_READV
#undef AT_PVM
#undef AT_SCHED_STAGE
    VM_WAIT(0);
    __syncthreads();
  }
#undef A_DMA
  const float inv = 1.f / (lrun + xhalf(lrun, h));
  u16* orow = O + (size_t)(w * 32 + l32) * ldo;
#pragma unroll
  for (int d = 0; d < DV / 32; ++d)
#pragma unroll
    for (int q = 0; q < 4; q += 2) {
      uint2 oa = {pk2(o[d][q * 4] * inv, o[d][q * 4 + 1] * inv), pk2(o[d][q * 4 + 2] * inv, o[d][q * 4 + 3] * inv)};
      uint2 ob = {pk2(o[d][q * 4 + 4] * inv, o[d][q * 4 + 5] * inv), pk2(o[d][q * 4 + 6] * inv, o[d][q * 4 + 7] * inv)};
      store_pair16(orow + d * 32 + q * 8, oa, ob, h);
    }
}

DI void gmlp_phase(const u16* __restrict__ z, const u16* __restrict__ ws_bf, const float* __restrict__ bs, u16* __restrict__ y, char* smem) {
  constexpr int VS = 64 * 2 + 64;
  const int t = tid_opaque(), lane = t & 63, w = t >> 6, l32 = lane & 31, h = lane >> 5;
  const int qq = (lane & 15) >> 2, pp = lane & 3, blk = (lane >> 4) & 1;
  for (int job = blockIdx.x; job < 512 * 2; job += gridDim.x) {
    const int chunk = job >> 1, grp = (job & 1) * 2 + (w >> 2);
    const size_t tok0 = (size_t)chunk * 128;
    char* const sm = smem + (w >> 2) * (128 * VS);
#pragma unroll
    for (int i = 0; i < 4; ++i) {
      int c = t + i * NTHR, gl = c >> 10, row = (c >> 3) & 127, vc = c & 7;
      uint4 v = *(const uint4*)(z + (tok0 + row) * DIN + 1312 + ((job & 1) * 2 + gl) * 64 + vc * 8);
      *(uint4*)(smem + gl * (128 * VS) + row * VS + vc * 16) = v;
    }
    __syncthreads();
    f32x16 acc[2];
#pragma unroll
    for (int d = 0; d < 2; ++d)
#pragma unroll
      for (int r = 0; r < 16; ++r) acc[d][r] = 0.f;
    const int p = (w & 3) * 32 + l32;
#pragma unroll
    for (int ks = 0; ks < 8; ++ks) {
      bf16x8 wf = *(const bf16x8*)(ws_bf + (size_t)grp * 16384 + p * 128 + ks * 16 + h * 8);
#pragma unroll
      for (int d = 0; d < 2; ++d) {
        const char* va = sm + (ks * 16 + 8 * h + qq) * VS + d * 64 + blk * 32 + pp * 8;
        s16x4 lo = __builtin_amdgcn_ds_read_tr16_b64_v4i16((lds_s16x4*)(va));
        s16x4 hi = __builtin_amdgcn_ds_read_tr16_b64_v4i16((lds_s16x4*)(va + 4 * VS));
        bf16x8 vf = __builtin_shufflevector(lo, hi, 0, 1, 2, 3, 4, 5, 6, 7);
        acc[d] = MFMA(vf, wf, acc[d]);
      }
    }
    const float bias = bs[grp * 128 + p];
    const u16* ur = z + (tok0 + p) * DIN + 1056 + grp * 64;
    u16* yr = y + (tok0 + p) * DM + 768 + grp * 64;
#pragma unroll
    for (int d = 0; d < 2; ++d)
#pragma unroll
      for (int q = 0; q < 4; q += 2) {
        uint2 ov[2];
#pragma unroll
        for (int k = 0; k < 2; ++k) {
          const int c = d * 32 + (q + k) * 8 + h * 4;
          uint2 u = *(const uint2*)(ur + c);
          ov[k].x = pk2(bflo(u.x) * (acc[d][(q + k) * 4] + bias), bfhi(u.x) * (acc[d][(q + k) * 4 + 1] + bias));
          ov[k].y = pk2(bflo(u.y) * (acc[d][(q + k) * 4 + 2] + bias), bfhi(u.y) * (acc[d][(q + k) * 4 + 3] + bias));
        }
        store_pair16(yr + d * 32 + q * 8, ov[0], ov[1], h);
      }
    __syncthreads();
  }
}

DI void grid_barrier(unsigned* ctr, unsigned& target) {
  __syncthreads();
  target += 1;
  if (threadIdx.x == 0) {
    __builtin_amdgcn_fence(__ATOMIC_RELEASE, "agent");
    unsigned* top = ctr;
    if ((gridDim.x & 7) == 0) {
      const unsigned gsz = gridDim.x >> 3;
      unsigned* gc = ctr + 32 * (1 + (blockIdx.x & 7));
      const unsigned old = __hip_atomic_fetch_add(gc, 1u, __ATOMIC_RELAXED, __HIP_MEMORY_SCOPE_AGENT);
      if (old + 1 == target * gsz) __hip_atomic_fetch_add(top, 1u, __ATOMIC_RELAXED, __HIP_MEMORY_SCOPE_AGENT);
      while (__hip_atomic_load(top, __ATOMIC_RELAXED, __HIP_MEMORY_SCOPE_AGENT) < target * 8u) __builtin_amdgcn_s_sleep(1);
    } else {
      __hip_atomic_fetch_add(top, 1u, __ATOMIC_RELAXED, __HIP_MEMORY_SCOPE_AGENT);
      while (__hip_atomic_load(top, __ATOMIC_RELAXED, __HIP_MEMORY_SCOPE_AGENT) < target * gridDim.x) __builtin_amdgcn_s_sleep(1);
    }
    __builtin_amdgcn_fence(__ATOMIC_ACQUIRE, "agent");
  }
  __syncthreads();
}

constexpr int SMEM_BYTES = 2 * G_STAGE;

__global__ void __launch_bounds__(512) fwd_megakernel(Params p) {
  cg::grid_group grid = cg::this_grid();
  __shared__ __attribute__((aligned(16))) char smem[SMEM_BYTES];
  char* ws = p.ws;
  u16* Wb = (u16*)(ws + OFF_W);
  float* cosA = (float*)(ws + OFF_ROPE);
  float* sinA = cosA + SEQ * 16;
  float* cosB = sinA + SEQ * 16;
  float* sinB = cosB + SEQ * 32;
  u16* memn = (u16*)(ws + OFF_MEMN);
  u16* memkv = (u16*)(ws + OFF_MEMKV);
  u16* H = (u16*)(ws + OFF_H);
  u16* Z = (u16*)(ws + OFF_Z);
  u16* Y = (u16*)(ws + OFF_Y);
  u16* QM = Y;
  u16* OM = (u16*)(ws + OFF_Y + 64 * MiB);
  u16* QA = (u16*)(ws + OFF_QA);
  u16* KA = (u16*)(ws + OFF_KA);
  u16* VA = (u16*)(ws + OFF_VA);
  float* X = p.out;
  unsigned* bar = (unsigned*)(ws + OFF_BAR);
  unsigned bar_target = 0;

  for (int l = 0; l < 2; ++l) {
    u16* wl = Wb + l * W_LAYER;
    transpose_phase(p.in[3] + (size_t)l * 1024 * 1568, 1024, 1568, wl + W_IN, false, smem);
    transpose_phase(p.in[5] + (size_t)l * 256 * 576, 256, 576, wl + W_UQ, false, smem);
    transpose_phase(p.in[7] + (size_t)l * 128 * 768, 128, 768, wl + W_UKV, false, smem);
    transpose_phase(p.in[14] + (size_t)l * 1024 * 1024, 1024, 1024, wl + W_OUT, false, smem);
    transpose_phase(p.in[17] + (size_t)l * 1024 * 512, 1024, 512, wl + W_MQ, false, smem);
    transpose_phase(p.in[18] + (size_t)l * 1024 * 1024, 1024, 1024, wl + W_MKV, false, smem);
    transpose_phase(p.in[19] + (size_t)l * 512 * 1024, 512, 1024, wl + W_MO, false, smem);
    transpose_phase(p.in[21] + (size_t)l * 1024 * 5632, 1024, 5632, wl + W_UP, true, smem);
    transpose_phase(p.in[24] + (size_t)l * 2816 * 1024, 2816, 1024, wl + W_DN, false, smem);
    const float* wsrc = p.in[11] + (size_t)l * 65536;
    for (int i = blockIdx.x * NTHR + tid_opaque(); i < 32768; i += gridDim.x * NTHR)
      *(unsigned*)(wl + W_S + i * 2) = pk2(wsrc[i * 2], wsrc[i * 2 + 1]);
    norm_rows_bf16(p.in[1], p.in[16] + l * DM, memn + (size_t)l * NMEM * DM, NMEM);
  }
  for (int i = blockIdx.x * NTHR + tid_opaque(); i < SEQ * 16; i += gridDim.x * NTHR) {
    int s = i >> 4, pi = i & 15;
    float pos = (pi < 8) ? (float)(s >> 6) : (float)(s & 63);
    float inv = powf(10000.f, -(float)(pi & 7) / 8.f);
    float ang = pos * inv;
    cosA[i] = cosf(ang); sinA[i] = sinf(ang);
  }
  for (int i = blockIdx.x * NTHR + tid_opaque(); i < SEQ * 32; i += gridDim.x * NTHR) {
    int s = i >> 5, pi = i & 31;
    float pos = (pi < 16) ? (float)(s >> 6) : (float)(s & 63);
    float inv = powf(10000.f, -(float)(pi & 15) / 16.f);
    float ang = pos * inv;
    cosB[i] = cosf(ang); sinB[i] = sinf(ang);
  }
  norm_rows_bf16(p.in[0], p.in[2], H, NTOK);
  grid.sync();

  for (int l = 0; l < 2; ++l) {
    GemmArgs g{};
    g.A = memn + (size_t)l * NMEM * DM; g.lda = DM; g.W = Wb + l * W_LAYER + W_MKV; g.ldw = DM;
    g.M = NMEM; g.N = 1024; g.K = 1024; g.epi = EPI_BF16; g.out = memkv + (size_t)l * NMEM * DM; g.ldo = DM; g.scale = 1.f;
    gemm_phase<false>(g, smem);
  }

  for (int l = 0; l < 2; ++l) {
    const u16* wl = Wb + l * W_LAYER;
    const float* xsrc = (l == 0) ? p.in[0] : X;
    {
      GemmArgs g{};
      g.A = H; g.lda = DM; g.W = wl + W_IN; g.ldw = DM; g.M = NTOK; g.N = DIN; g.K = DM; g.epi = EPI_BF16;
      g.out = Z; g.ldo = DIN; g.scale = 1.f;
      gemm_phase<false>(g, smem);
    }
    grid_barrier(bar, bar_target);
    {
      PostArgs a;
      a.z = Z; a.ka = KA;
      a.qn = p.in[4] + l * 256; a.kvn = p.in[6] + l * 128; a.gq = p.in[8] + l * 64; a.gk = p.in[9] + l * 64; a.gv = p.in[10] + l * 256;
      a.cosA = cosA; a.sinA = sinA; a.cosB = cosB; a.sinB = sinB;
      post_phase(a);
    }
    grid_barrier(bar, bar_target);
    {
      GemmArgs g{};
      g.A = Z; g.lda = DIN; g.W = wl + W_UQ; g.ldw = 256; g.M = NTOK; g.N = 576; g.K = 256; g.epi = EPI_QA;
      g.out = QA; g.ldo = 576; g.scale = 0.10206207261596575f * LOG2E; g.cosA = cosA; g.sinA = sinA;
      gemm_phase<false>(g, smem);
      GemmArgs g2{};
      g2.A = Z + 256; g2.lda = DIN; g2.W = wl + W_UKV; g2.ldw = 128; g2.M = NTOK; g2.N = 768; g2.K = 128; g2.epi = EPI_KVA;
      g2.out = KA; g2.out2 = VA;
      gemm_phase<false>(g2, smem);
      gmlp_phase(Z, wl + W_S, p.in[12] + l * 512, Y, smem);
    }
    grid_barrier(bar, bar_target);
    for (int jb = blockIdx.x; jb < 256; jb += gridDim.x) {
      const int b = jb & 7, qt = jb >> 3;
      const size_t tq = (size_t)b * SEQ + qt * 256, tk = (size_t)b * SEQ;
#pragma unroll 1
      for (int hd = 0; hd < 6; ++hd)
        attn_block_dma<96>(QA + tq * 576 + hd * 96, 576, KA + tk * 576 + hd * 96, 576, VA + tk * 384 + hd * 64, 384,
                           Y + tq * DM + hd * 64, DM, SEQ, smem);
#pragma unroll 1
      for (int hd = 0; hd < 6; ++hd) {
        const int kvh = hd / 3;
        attn_block_dma<64>(Z + tq * DIN + 416 + hd * 64, DIN, Z + tk * DIN + 800 + kvh * 64, DIN, Z + tk * DIN + 928 + kvh * 64, DIN,
                           Y + tq * DM + 384 + hd * 64, DM, SEQ, smem);
      }
      __builtin_amdgcn_fence(__ATOMIC_RELEASE, "workgroup");
      __syncthreads();
      __builtin_amdgcn_fence(__ATOMIC_ACQUIRE, "agent");
      outnorm_rows(Y, p.in[13] + l * DM, H, (int)tq);
    }
    grid_barrier(bar, bar_target);
    {
      GemmArgs g{};
      g.A = H; g.lda = DM; g.W = wl + W_OUT; g.ldw = DM; g.M = NTOK; g.N = DM; g.K = DM; g.epi = EPI_RESID;
      g.res = xsrc; g.outf = X;
      gemm_phase<false>(g, smem);
    }
    grid_barrier(bar, bar_target);
    norm_rows_bf16(X, p.in[15] + l * DM, H, NTOK);
    grid_barrier(bar, bar_target);
    {
      GemmArgs g{};
      g.A = H; g.lda = DM; g.W = wl + W_MQ; g.ldw = DM; g.M = NTOK; g.N = 512; g.K = DM; g.epi = EPI_BF16;
      g.out = QM; g.ldo = 512; g.scale = 0.08838834764831845f * LOG2E;
      gemm_phase<false>(g, smem);
    }
    grid_barrier(bar, bar_target);
    for (int j = blockIdx.x; j < 1024; j += gridDim.x) {
      const int x = j & 7, jj = j >> 3;
      const int pair = x + 8 * (jj >> 5), qt = jj & 31;
      const int b = pair >> 2, hd = pair & 3;
      const size_t tq = (size_t)b * SEQ + qt * 256;
      const u16* kv = memkv + (size_t)l * NMEM * DM + (size_t)b * 256 * DM;
      attn_block<128, 128>(QM + tq * 512 + hd * 128, 512, kv + hd * 128, DM, kv + 512 + hd * 128, DM, OM + tq * 512 + hd * 128, 512, 256, smem);
    }
    grid_barrier(bar, bar_target);
    {
      GemmArgs g{};
      g.A = OM; g.lda = 512; g.W = wl + W_MO; g.ldw = 512; g.M = NTOK; g.N = DM; g.K = 512; g.epi = EPI_RESID;
      g.res = X; g.outf = X;
      gemm_phase<false>(g, smem);
    }
    grid_barrier(bar, bar_target);
    norm_rows_bf16(X, p.in[20] + l * DM, H, NTOK);
    grid_barrier(bar, bar_target);
    {
      GemmArgs g{};
      g.A = H; g.lda = DM; g.W = wl + W_UP; g.ldw = DM; g.M = NTOK; g.N = 2 * DFF; g.K = DM; g.epi = 0;
      g.out = Z; g.convw = p.in[22] + (size_t)l * 3 * 2 * DFF; g.convb = p.in[23] + (size_t)l * 2 * DFF;
      gemm_phase<true>(g, smem);
    }
    grid_barrier(bar, bar_target);
    {
      GemmArgs g{};
      g.A = Z; g.lda = DFF; g.W = wl + W_DN; g.ldw = DFF; g.M = NTOK; g.N = DM; g.K = DFF; g.epi = EPI_RESID;
      g.res = X; g.outf = X;
      gemm_phase<false>(g, smem);
    }
    grid_barrier(bar, bar_target);
    if (l == 0) {
      norm_rows_bf16(X, p.in[2] + DM, H, NTOK);
    } else {
      final_norm_rows(X, p.in[25], NTOK);
    }
    if (l == 0) grid_barrier(bar, bar_target);
  }
}

extern "C" void kernel_launch(void* const* d_in, const int* in_sizes, int n_in, void* d_out, int out_size, void* d_ws, size_t ws_size,
                              hipStream_t stream) {
  static int grid_blocks = 0;
  if (!grid_blocks) {
    int dev = 0, cus = 0, per_cu = 0;
    hipGetDevice(&dev);
    hipDeviceGetAttribute(&cus, hipDeviceAttributeMultiprocessorCount, dev);
    hipOccupancyMaxActiveBlocksPerMultiprocessor(&per_cu, fwd_megakernel, NTHR, 0);
    if (per_cu > 1) per_cu = 1;
    if (per_cu < 1) per_cu = 1;
    grid_blocks = cus * per_cu;
  }
  Params p{};
  for (int i = 0; i < 26; ++i) p.in[i] = (const float*)d_in[i];
  p.out = (float*)d_out;
  p.ws = (char*)d_ws;
  hipMemsetAsync((char*)d_ws + OFF_BAR, 0, 2048, stream);
  void* args[] = {&p};
  hipError_t e = hipLaunchCooperativeKernel((void*)fwd_megakernel, dim3(grid_blocks), dim3(NTHR), args, 0, stream);
  if (e != hipSuccess) fprintf(stderr, "cooperative launch failed: %s (grid %d)\n", hipGetErrorString(e), grid_blocks);
}
```
